# Optimizing an MI355X kernel written in HIP

```python
import math
import jax, jax.numpy as jnp
from jax import lax
import numpy as np

D_MODEL = 1024
BATCH = 32
SEQ = 2048
DEPTH = 2

N_MIXERS = 2
CONV_WIDTH = 3
HEAD_DIM = 64
N_Q_HEADS = D_MODEL // HEAD_DIM
N_KV_HEADS = 4
GROUP = N_Q_HEADS // N_KV_HEADS
WINDOW = 128
BLOCK = 128
D_FF = ((8 * D_MODEL // 3 + 255) // 256) * 256
QKV_WIDTH = (N_Q_HEADS + 2 * N_KV_HEADS) * HEAD_DIM
N_CONV_LAYERS = (DEPTH + 1) // 2
N_ATTN_LAYERS = DEPTH // 2
EPS = 1e-6

kernel_name = "hybrid_shortconv_swa_sink_alibi_swiglu"


def rmsnorm(x, gain):
    xf = x.astype(jnp.float32)
    r = lax.rsqrt(jnp.mean(xf * xf, axis=-1, keepdims=True) + EPS)
    return (xf * r).astype(x.dtype) * gain


def alibi_slopes():
    h = jnp.arange(1, N_Q_HEADS + 1, dtype=jnp.float32)
    return jnp.exp2(-8.0 * h / N_Q_HEADS)


def short_conv_mixer(h, w_in, conv_w, w_out):
    d = h.shape[-1]
    bcx = h @ w_in
    b_gate, c_gate, xv = jnp.split(bcx, 3, axis=-1)
    u = b_gate * xv
    y = lax.conv_general_dilated(
        u, conv_w[:, None, :].astype(u.dtype),
        window_strides=(1,), padding=[(CONV_WIDTH - 1, 0)],
        dimension_numbers=('NWC', 'WIO', 'NWC'), feature_group_count=d)
    return (c_gate * y) @ w_out


def swa_sink_attention(h, w_qkv, q_gain, k_gain, sinks, w_o):
    bsz, s, _ = h.shape
    nb = s // BLOCK
    qkv = h @ w_qkv
    q_end = N_Q_HEADS * HEAD_DIM
    k_end = q_end + N_KV_HEADS * HEAD_DIM
    q = qkv[..., :q_end].reshape(bsz, s, N_KV_HEADS, GROUP, HEAD_DIM)
    k = qkv[..., q_end:k_end].reshape(bsz, s, N_KV_HEADS, HEAD_DIM)
    v = qkv[..., k_end:].reshape(bsz, s, N_KV_HEADS, HEAD_DIM)
    q = rmsnorm(q, q_gain)
    k = rmsnorm(k, k_gain)

    qb = q.reshape(bsz, nb, BLOCK, N_KV_HEADS, GROUP, HEAD_DIM)

    def band(t):
        tp = jnp.pad(t, ((0, 0), (BLOCK, 0), (0, 0), (0, 0)))
        tb = tp.reshape(bsz, nb + 1, BLOCK, N_KV_HEADS, HEAD_DIM)
        return jnp.concatenate([tb[:, :-1], tb[:, 1:]], axis=2)

    kw = band(k)
    vw = band(v)

    scale = 1.0 / math.sqrt(HEAD_DIM)
    scores = jnp.einsum('bnqkgd,bnskd->bnkgqs', qb, kw).astype(jnp.float32) * scale

    qi = jnp.arange(BLOCK)[:, None]
    kj = jnp.arange(2 * BLOCK)[None, :]
    dist = qi + BLOCK - kj
    key_pos = (jnp.arange(nb) * BLOCK - BLOCK)[:, None, None] + kj[None]
    mask = (dist >= 0)[None] & (dist < WINDOW)[None] & (key_pos >= 0)

    slopes = alibi_slopes().reshape(N_KV_HEADS, GROUP)
    alibi = -slopes[:, :, None, None] * dist.astype(jnp.float32)[None, None]
    scores = scores + alibi[None, None]
    scores = jnp.where(mask[None, :, None, None], scores, -jnp.inf)

    sink = sinks.astype(jnp.float32).reshape(N_KV_HEADS, GROUP)
    sink_col = jnp.broadcast_to(sink[None, None, :, :, None, None],
                                scores.shape[:-1] + (1,))
    logits = jnp.concatenate([scores, sink_col], axis=-1)
    p = jax.nn.softmax(logits, axis=-1)[..., :-1]

    out = jnp.einsum('bnkgqs,bnskd->bnqkgd', p.astype(vw.dtype), vw)
    out = out.reshape(bsz, s, N_Q_HEADS * HEAD_DIM)
    return out @ w_o


def swiglu_ffn(h, w_gate_up, w_down):
    gu = h @ w_gate_up
    g, u = jnp.split(gu, 2, axis=-1)
    return (jax.nn.silu(g) * u) @ w_down


def setup_inputs(seed: int = 0) -> dict:
    key = jax.random.key(seed)
    ks = jax.random.split(key, 14)
    f32 = jnp.float32
    d = D_MODEL

    def w(k, shape, fan_in):
        return jax.random.normal(k, shape, f32) * (fan_in ** -0.5)

    return {
        "x": jax.random.normal(ks[0], (BATCH, SEQ, d), f32),
        "conv_w_in": w(ks[1], (N_CONV_LAYERS, d, 3 * d), d),
        "conv_w": w(ks[2], (N_CONV_LAYERS, CONV_WIDTH, d), CONV_WIDTH),
        "conv_w_out": w(ks[3], (N_CONV_LAYERS, d, d), d),
        "attn_w_qkv": w(ks[4], (N_ATTN_LAYERS, d, QKV_WIDTH), d),
        "attn_q_gain": 1.0 + 0.05 * jax.random.normal(ks[5], (N_ATTN_LAYERS, HEAD_DIM), f32),
        "attn_k_gain": 1.0 + 0.05 * jax.random.normal(ks[6], (N_ATTN_LAYERS, HEAD_DIM), f32),
        "attn_sinks": 0.5 * jax.random.normal(ks[7], (N_ATTN_LAYERS, N_Q_HEADS), f32),
        "attn_w_o": w(ks[8], (N_ATTN_LAYERS, N_Q_HEADS * HEAD_DIM, d), N_Q_HEADS * HEAD_DIM),
        "norm_mixer": 1.0 + 0.05 * jax.random.normal(ks[9], (DEPTH, d), f32),
        "norm_ffn": 1.0 + 0.05 * jax.random.normal(ks[10], (DEPTH, d), f32),
        "ffn_w_gate_up": w(ks[11], (DEPTH, d, 2 * D_FF), d),
        "ffn_w_down": w(ks[12], (DEPTH, D_FF, d), D_FF),
    }


def reference(x, conv_w_in, conv_w, conv_w_out, attn_w_qkv, attn_q_gain, attn_k_gain,
              attn_sinks, attn_w_o, norm_mixer, norm_ffn, ffn_w_gate_up, ffn_w_down):
    for i in range(DEPTH):
        h = rmsnorm(x, norm_mixer[i])
        j = i // N_MIXERS
        if i % N_MIXERS == 0:
            mix = short_conv_mixer(h, conv_w_in[j], conv_w[j], conv_w_out[j])
        else:
            mix = swa_sink_attention(h, attn_w_qkv[j], attn_q_gain[j], attn_k_gain[j],
                                     attn_sinks[j], attn_w_o[j])
        x = x + mix
        h = rmsnorm(x, norm_ffn[i])
        x = x + swiglu_ffn(h, ffn_w_gate_up[i], ffn_w_down[i])
    return x
```

```cpp
#include <hip/hip_runtime.h>
#include <hip/hip_cooperative_groups.h>
#include <cstdio>
#include <cstdint>
namespace cg = cooperative_groups;


#define LAS __attribute__((address_space(3)))
typedef unsigned short bf16_t;
typedef short bf16x8 __attribute__((ext_vector_type(8)));
typedef short s16x4 __attribute__((ext_vector_type(4)));
typedef float f32x4 __attribute__((ext_vector_type(4)));
typedef float f32x16 __attribute__((ext_vector_type(16)));
typedef unsigned u32x4 __attribute__((ext_vector_type(4)));
typedef unsigned u32x2 __attribute__((ext_vector_type(2)));

constexpr int M = 65536, D = 1024, DFF = 2816, SEQ = 2048, NQKV = 1536;
constexpr float EPS = 1e-6f, LOG2E = 1.4426950408889634f;

__device__ __forceinline__ unsigned cvt_pk_bf16(float lo, float hi) { unsigned r; asm volatile("v_cvt_pk_bf16_f32 %0, %1, %2" : "=v"(r) : "v"(lo), "v"(hi)); return r; }
__device__ __forceinline__ int lane_id() { int l; asm volatile("v_mbcnt_lo_u32_b32 %0, -1, 0\n\tv_mbcnt_hi_u32_b32 %0, -1, %0" : "=v"(l)); return l; }
__device__ __forceinline__ float bf_lo(unsigned w) { return __builtin_bit_cast(float, w << 16); }
__device__ __forceinline__ float bf_hi(unsigned w) { return __builtin_bit_cast(float, w & 0xffff0000u); }

namespace pg8 {
constexpr int BM = 256, BK = 64, HALF = 128, HTB = HALF * BK * 2, STAGE_BYTES = 8 * HTB, NXCD = 8, WGM = 8;
__host__ __device__ __forceinline__ int lds_byte(int r, int c) { const int st = (r >> 4) * 2 + (c >> 5), rr = r & 15, cc = c & 31, ob = rr * 64 + cc * 2; return st * 1024 + (ob ^ (((ob >> 9) & 1) << 5)); }
__host__ __device__ __forceinline__ void stage_rc(int b, int& R, int& C) { const int st = b / 1024, sb = b % 1024, swz = sb ^ (((sb >> 9) & 1) << 5); R = (st >> 1) * 16 + swz / 64; C = (st & 1) * 32 + (swz % 64) / 2; }
__host__ __device__ __forceinline__ int perm32(int rho) { const int n = rho >> 4, i = rho & 15; return 8 * (i >> 2) + 4 * n + (i & 3); }

struct Unit { int pm, pn; };
struct Gemm { const bf16_t* A; const bf16_t* Bt; int M, N, K; };

struct StaticOrder {
    int nM, nN, nwg, G, c;
    __host__ __device__ void init(int M_, int N_, int G_, int c_) { nM = M_ / BM; nN = N_ / BM; nwg = nM * nN; G = G_; c = c_; }
    __host__ __device__ bool next(int i, Unit& u) const {
        const long L = (long)i * G + c; if (L >= nwg) return false;
        int wgid = (int)L; { const int q = nwg / NXCD, r = nwg % NXCD, xcd = wgid % NXCD, off = wgid / NXCD; wgid = (xcd < r ? xcd * (q + 1) : r * (q + 1) + (xcd - r) * q) + off; }
        const int nig = WGM * nN, gid = wgid / nig, fm = gid * WGM, gsz = (nM - fm) < WGM ? (nM - fm) : WGM;
        u.pm = fm + ((wgid % nig) % gsz); u.pn = (wgid % nig) / gsz; return true;
    }
};

template <class Epi, bool ALIGN_EPI = true, bool ATILED = false>
__device__ __forceinline__ void gemm_phase(LAS unsigned char* lds, const Gemm g, const StaticOrder& S, const Epi& E, int wid) {
    const int lane = lane_id(), tid = wid * 64 + lane, wr = wid >> 2, wc = wid & 3, fr = lane & 15, fq = lane >> 4;
    const int K = g.K, nt = K / BK;
    unsigned voffA[2], voffB[2];
#pragma unroll
    for (int i = 0; i < 2; ++i) { int R, C; stage_rc(tid * 16 + i * 8192, R, C); const int Rb = Epi::PERM ? ((R & ~31) + perm32(R & 31)) : R;
        voffA[i] = ATILED ? (unsigned)(R * BK + C) * 2u : (unsigned)(R * K + C) * 2u; voffB[i] = (unsigned)(Rb * K + C) * 2u; }
    const size_t kstep = (size_t)(BK * 2);
    const size_t hstep = (size_t)HALF * K * 2;
    const size_t tstep = 2 * hstep;
    const size_t kstepA = ATILED ? (size_t)BM * BK * 2 : kstep, hstepA = ATILED ? (size_t)HALF * BK * 2 : hstep;
    const unsigned ldsw = (unsigned)wid * 1024u;
    const int aoff = lds_byte(wr * 64 + fr, fq * 8), boff = lds_byte(wc * 32 + fr, fq * 8);
#define PG8_SA(b, h) (((b) * 2 + (h)) * HTB)
#define PG8_SB(b, h) ((4 + (b) * 2 + (h)) * HTB)
#define PG8_STAGE(bufoff, gbase, voff) do { _Pragma("unroll") for (int _i = 0; _i < 2; ++_i) \
        __builtin_amdgcn_global_load_lds((const unsigned*)((const char*)(gbase) + (voff)[_i]), (LAS unsigned*)(lds + (bufoff) + ldsw + _i * 8192), 16, 0, 0); } while (0)
#define PG8_LDA(dst, b, h) do { _Pragma("unroll") for (int m = 0; m < 4; ++m) _Pragma("unroll") for (int k = 0; k < 2; ++k) dst[m][k] = *(const LAS bf16x8*)(lds + PG8_SA(b, h) + aoff + m * 2048 + k * 1024); } while (0)
#define PG8_LDB(dst, b, h) do { _Pragma("unroll") for (int n = 0; n < 2; ++n) _Pragma("unroll") for (int k = 0; k < 2; ++k) dst[n][k] = *(const LAS bf16x8*)(lds + PG8_SB(b, h) + boff + n * 2048 + k * 1024); } while (0)
#define PG8_MMA(ai, bj, At, Bt) do { __builtin_amdgcn_s_setprio(1); _Pragma("unroll") for (int m = 0; m < 4; ++m) _Pragma("unroll") for (int n = 0; n < 2; ++n) _Pragma("unroll") for (int k = 0; k < 2; ++k) \
        acc[ai][bj][m][n] = __builtin_amdgcn_mfma_f32_16x16x32_bf16(Bt[n][k], At[m][k], acc[ai][bj][m][n], 0, 0, 0); __builtin_amdgcn_s_setprio(0); } while (0)
#define PG8_WAIT_V(n) asm volatile("s_waitcnt vmcnt(" #n ")" ::: "memory")
#define PG8_WAIT_L(n) asm volatile("s_waitcnt lgkmcnt(" #n ")" ::: "memory")
#define PG8_BAR __builtin_amdgcn_s_barrier()
#define PG8_SCHED __builtin_amdgcn_sched_barrier(0)
    Unit cur, nxt; int ui = 0;
    if (!S.next(0, cur)) return;
    f32x4 acc[2][2][4][2];
    E.init_acc(acc, cur, wr, wc, fr, fq);
    int rpm = -1, rbuf = 0;
    bf16x8 At[4][2], B0[2][2], B1[2][2];
    const char* cA = (const char*)g.A + (size_t)cur.pm * tstep; const char* cB = (const char*)g.Bt + (size_t)cur.pn * tstep;
    PG8_STAGE(PG8_SB(0, 0), cB, voffB); PG8_STAGE(PG8_SB(0, 1), cB + hstep, voffB); PG8_STAGE(PG8_SA(0, 0), cA, voffA); PG8_STAGE(PG8_SA(0, 1), cA + hstepA, voffA);
    if (wr == 1) PG8_BAR;
    PG8_WAIT_V(2); PG8_BAR;
    PG8_STAGE(PG8_SB(1, 0), cB + kstep, voffB); PG8_STAGE(PG8_SA(1, 0), cA + kstepA, voffA); PG8_STAGE(PG8_SB(1, 1), cB + hstep + kstep, voffB);
    PG8_WAIT_V(6); PG8_BAR;
    for (;;) {
        const bool has_next = S.next(ui + 1, nxt);
        const char* nA = has_next ? (const char*)g.A + (size_t)nxt.pm * tstep : cA; const char* nB = has_next ? (const char*)g.Bt + (size_t)nxt.pn * tstep : cB;
        if constexpr (Epi::RSTD) { if (cur.pm != rpm) { rbuf ^= 1; rpm = cur.pm; E.fill_rstd((LAS float*)(lds + STAGE_BYTES) + rbuf * 256, cur.pm, tid); } }
        if constexpr (Epi::INIT_BASE) E.finish_init(acc);
        for (int t = 0; t < nt; t += 2) {
            const bool last = (t == nt - 2);
            const char* a1 = cA + (size_t)(t + 1) * kstepA;
            const char* a2 = last ? nA : cA + (size_t)(t + 2) * kstepA; const char* b2 = last ? nB : cB + (size_t)(t + 2) * kstep;
            const char* a3 = a2 + kstepA; const char* b3 = b2 + kstep;
            PG8_LDB(B0, 0, 0); PG8_LDB(B1, 0, 1); PG8_SCHED; PG8_LDA(At, 0, 0); PG8_STAGE(PG8_SA(1, 1), a1 + hstepA, voffA);
            PG8_WAIT_V(8); PG8_WAIT_L(0); PG8_BAR; PG8_MMA(0, 0, At, B0); PG8_MMA(0, 1, At, B1); PG8_BAR; PG8_SCHED;
            PG8_LDA(At, 0, 1); PG8_STAGE(PG8_SB(0, 0), b2, voffB); PG8_STAGE(PG8_SB(0, 1), b2 + hstep, voffB); PG8_STAGE(PG8_SA(0, 0), a2, voffA);
            PG8_WAIT_V(8); PG8_WAIT_L(0); PG8_BAR; PG8_MMA(1, 0, At, B0); PG8_MMA(1, 1, At, B1); PG8_BAR; PG8_SCHED;
            PG8_LDB(B0, 1, 0); PG8_LDB(B1, 1, 1); PG8_SCHED; PG8_LDA(At, 1, 0); PG8_STAGE(PG8_SA(0, 1), a2 + hstepA, voffA);
            PG8_WAIT_V(8); PG8_WAIT_L(0); PG8_BAR; PG8_MMA(0, 0, At, B0); PG8_MMA(0, 1, At, B1); PG8_BAR; PG8_SCHED;
            PG8_LDA(At, 1, 1); PG8_STAGE(PG8_SB(1, 0), b3, voffB); PG8_STAGE(PG8_SB(1, 1), b3 + hstep, voffB); PG8_STAGE(PG8_SA(1, 0), a3, voffA);
            PG8_WAIT_V(8); PG8_WAIT_L(0); PG8_BAR; PG8_MMA(1, 0, At, B0); PG8_MMA(1, 1, At, B1); PG8_BAR; PG8_SCHED;
        }
        if constexpr (ALIGN_EPI) { if (wr == 0) PG8_BAR; }
        E(acc, cur, has_next, nxt, (const LAS float*)(lds + STAGE_BYTES) + rbuf * 256, wr, wc, fr, fq);
        if (!has_next) break;
        cur = nxt; cA = nA; cB = nB; ++ui;
        if constexpr (ALIGN_EPI) { if (wr == 1) PG8_BAR; }
    }
    PG8_WAIT_V(0);
    if constexpr (!ALIGN_EPI) { if (wr == 0) PG8_BAR; }
    PG8_BAR;
#undef PG8_SA
#undef PG8_SB
#undef PG8_STAGE
#undef PG8_LDA
#undef PG8_LDB
#undef PG8_MMA
#undef PG8_WAIT_V
#undef PG8_WAIT_L
#undef PG8_BAR
#undef PG8_SCHED
}
}

typedef f32x4 AccT[2][2][4][2];
__device__ __forceinline__ void zero_acc(AccT& acc) {
#pragma unroll
    for (int a = 0; a < 2; ++a)
#pragma unroll
        for (int b = 0; b < 2; ++b)
#pragma unroll
            for (int m = 0; m < 4; ++m)
#pragma unroll
                for (int n = 0; n < 2; ++n) acc[a][b][m][n] = (f32x4){0.f, 0.f, 0.f, 0.f};
}
__device__ __forceinline__ void fill_rstd_tbl(const float* ssq, LAS float* dst, int pm, int tid) {
    const int row = tid >> 1, hf = tid & 1;
    const f32x4* p = (const f32x4*)(ssq + (size_t)(pm * 256 + row) * 16 + hf * 8);
    const f32x4 a = p[0], b = p[1];
    float s = ((a[0] + a[1]) + (a[2] + a[3])) + ((b[0] + b[1]) + (b[2] + b[3]));
    s += __shfl_xor(s, 1);
    if (hf == 0) dst[row] = 1.0f / sqrtf(s * (1.0f / 1024.0f) + EPS);
}
__device__ __forceinline__ void load_rstd(const LAS float* tbl, int wr, int fr, float (&rs)[2][4]) {
#pragma unroll
    for (int ai = 0; ai < 2; ++ai)
#pragma unroll
        for (int m = 0; m < 4; ++m) rs[ai][m] = tbl[ai * 128 + wr * 64 + m * 16 + fr];
}
__device__ __forceinline__ float silu_f(float x) { return x * __builtin_amdgcn_rcpf(1.0f + __builtin_amdgcn_exp2f(-x * LOG2E)); }

struct EpiU {
    static constexpr bool PERM = true, RSTD = true, INIT_BASE = false;
    bf16_t* U; const float* ssq;
    __device__ __forceinline__ void init_acc(AccT& acc, const pg8::Unit&, int, int, int, int) const { zero_acc(acc); }
    __device__ __forceinline__ void fill_rstd(LAS float* dst, int pm, int tid) const { fill_rstd_tbl(ssq, dst, pm, tid); }
    __device__ __forceinline__ void operator()(AccT& acc, const pg8::Unit& u, bool, const pg8::Unit&, const LAS float* tbl, int wr, int wc, int fr, int fq) const {
        const int row0 = u.pm * 256 + wr * 64 + fr;
        float rs[2][4]; load_rstd(tbl, wr, fr, rs);
        const int col0 = u.pn * 128 + wc * 32 + 8 * fq;
#pragma unroll
        for (int ai = 0; ai < 2; ++ai)
#pragma unroll
            for (int m = 0; m < 4; ++m) {
                const float r2 = rs[ai][m] * rs[ai][m];
                const f32x4 v0 = acc[ai][0][m][0] * acc[ai][1][m][0] * r2, v1 = acc[ai][0][m][1] * acc[ai][1][m][1] * r2;
                u32x4 w; w.x = cvt_pk_bf16(v0[0], v0[1]); w.y = cvt_pk_bf16(v0[2], v0[3]); w.z = cvt_pk_bf16(v1[0], v1[1]); w.w = cvt_pk_bf16(v1[2], v1[3]);
                *(u32x4*)(U + (size_t)(row0 + ai * 128 + m * 16) * D + col0) = w;
            }
        zero_acc(acc);
    }
};
struct EpiCz {
    static constexpr bool PERM = true, RSTD = true, INIT_BASE = false;
    const bf16_t* U; bf16_t* Z; const float* ssq; const LAS float* cw;
    __device__ __forceinline__ void init_acc(AccT& acc, const pg8::Unit&, int, int, int, int) const { zero_acc(acc); }
    __device__ __forceinline__ void fill_rstd(LAS float* dst, int pm, int tid) const { fill_rstd_tbl(ssq, dst, pm, tid); }
    __device__ __forceinline__ static unsigned ror_(unsigned p, int n) { return n == 1 ? (unsigned)__builtin_amdgcn_update_dpp(0, (int)p, 0x121, 0xf, 0xf, true) : (unsigned)__builtin_amdgcn_update_dpp(0, (int)p, 0x122, 0xf, 0xf, true); }
    __device__ __forceinline__ static unsigned above_(unsigned prev, unsigned cur, int n) {
        const unsigned old = ror_(prev, n);
        return n == 1 ? (unsigned)__builtin_amdgcn_update_dpp((int)old, (int)cur, 0x111, 0xf, 0xf, false) : (unsigned)__builtin_amdgcn_update_dpp((int)old, (int)cur, 0x112, 0xf, 0xf, false);
    }
    __device__ __forceinline__ void operator()(AccT& acc, const pg8::Unit& u, bool, const pg8::Unit&, const LAS float* tbl, int wr, int wc, int fr, int fq) const {
        const int row0 = u.pm * 256 + wr * 64 + fr;
        const int ch0 = u.pn * 256 + wc * 32 + 8 * fq;
        u32x4 uu[2][4][2], hh[2][2];
#define CZ_LOAD(ai) do { _Pragma("unroll") for (int bj = 0; bj < 2; ++bj) { hh[ai][bj] = (u32x4){0u, 0u, 0u, 0u}; const int hr = row0 + (ai) * 128 - 16; \
            if (fr >= 14 && hr >= 0) hh[ai][bj] = *(const u32x4*)(U + (size_t)hr * D + ch0 + bj * 128); } \
        _Pragma("unroll") for (int m = 0; m < 4; ++m) _Pragma("unroll") for (int bj = 0; bj < 2; ++bj) uu[ai][m][bj] = *(const u32x4*)(U + (size_t)(row0 + (ai) * 128 + m * 16) * D + ch0 + bj * 128); } while (0)
#define CZ_GROUP(ai, m) do { const int row = row0 + (ai) * 128 + (m) * 16; const float r = rs[ai][m]; \
        _Pragma("unroll") for (int bj = 0; bj < 2; ++bj) { const LAS float* wp = cw + ch0 + bj * 128; \
            const u32x4 u0 = uu[ai][m][bj], pv = ((m) == 0) ? hh[ai][bj] : uu[ai][(m) == 0 ? 0 : (m) - 1][bj]; u32x4 u1, u2; \
            _Pragma("unroll") for (int k = 0; k < 4; ++k) { u1[k] = above_(pv[k], u0[k], 1); u2[k] = above_(pv[k], u0[k], 2); } \
            if ((ai) == 0 && (m) == 0) { const int t = row & (SEQ - 1); if (t < 1) u1 = (u32x4){0u, 0u, 0u, 0u}; if (t < 2) u2 = (u32x4){0u, 0u, 0u, 0u}; } \
            f32x4 z[2]; \
            _Pragma("unroll") for (int n = 0; n < 2; ++n) { \
                const f32x4 w0 = *(const LAS f32x4*)(wp + 4 * n), w1 = *(const LAS f32x4*)(wp + D + 4 * n), w2 = *(const LAS f32x4*)(wp + 2 * D + 4 * n); \
                const f32x4 a0 = (f32x4){bf_lo(u0[2 * n]), bf_hi(u0[2 * n]), bf_lo(u0[2 * n + 1]), bf_hi(u0[2 * n + 1])}; \
                const f32x4 a1 = (f32x4){bf_lo(u1[2 * n]), bf_hi(u1[2 * n]), bf_lo(u1[2 * n + 1]), bf_hi(u1[2 * n + 1])}; \
                const f32x4 a2 = (f32x4){bf_lo(u2[2 * n]), bf_hi(u2[2 * n]), bf_lo(u2[2 * n + 1]), bf_hi(u2[2 * n + 1])}; \
                z[n] = (acc[ai][bj][m][n] * r) * (w0 * a2 + w1 * a1 + w2 * a0); } \
            u32x4 w; w.x = cvt_pk_bf16(z[0][0], z[0][1]); w.y = cvt_pk_bf16(z[0][2], z[0][3]); w.z = cvt_pk_bf16(z[1][0], z[1][1]); w.w = cvt_pk_bf16(z[1][2], z[1][3]); \
            *(u32x4*)(Z + (size_t)row * D + ch0 + bj * 128) = w; } } while (0)
        CZ_LOAD(0);
        float rs[2][4]; load_rstd(tbl, wr, fr, rs);
        __builtin_amdgcn_sched_barrier(0);
        CZ_GROUP(0, 0); CZ_GROUP(0, 1); CZ_GROUP(0, 2);
        __builtin_amdgcn_sched_barrier(0);
        CZ_LOAD(1);
        __builtin_amdgcn_sched_barrier(0);
        CZ_GROUP(0, 3);
        CZ_GROUP(1, 0); CZ_GROUP(1, 1); CZ_GROUP(1, 2); CZ_GROUP(1, 3);
#undef CZ_LOAD
#undef CZ_GROUP
        zero_acc(acc);
    }
};
struct EpiGu {
    static constexpr bool PERM = true, RSTD = true, INIT_BASE = false;
    bf16_t* ACT; const float* ssq;
    __device__ __forceinline__ void init_acc(AccT& acc, const pg8::Unit&, int, int, int, int) const { zero_acc(acc); }
    __device__ __forceinline__ void fill_rstd(LAS float* dst, int pm, int tid) const { fill_rstd_tbl(ssq, dst, pm, tid); }
    __device__ __forceinline__ void operator()(AccT& acc, const pg8::Unit& u, bool, const pg8::Unit&, const LAS float* tbl, int wr, int wc, int fr, int fq) const {
        const int row0 = u.pm * 256 + wr * 64 + fr;
        float rs[2][4]; load_rstd(tbl, wr, fr, rs);
        const int col0 = u.pn * 128 + wc * 32 + 8 * fq;
#pragma unroll
        for (int ai = 0; ai < 2; ++ai)
#pragma unroll
            for (int m = 0; m < 4; ++m) {
                const float r = rs[ai][m], r2 = r * r, nrl = -r * LOG2E;
                f32x4 v[2];
#pragma unroll
                for (int n = 0; n < 2; ++n) {
                    const f32x4 gg = acc[ai][0][m][n], p = (gg * acc[ai][1][m][n]) * r2, t = gg * nrl;
                    f32x4 d;
#pragma unroll
                    for (int i = 0; i < 4; ++i) d[i] = __builtin_amdgcn_exp2f(t[i]);
                    d = d + 1.0f;
#pragma unroll
                    for (int i = 0; i < 4; ++i) d[i] = __builtin_amdgcn_rcpf(d[i]);
                    v[n] = p * d;
                }
                u32x4 w; w.x = cvt_pk_bf16(v[0][0], v[0][1]); w.y = cvt_pk_bf16(v[0][2], v[0][3]); w.z = cvt_pk_bf16(v[1][0], v[1][1]); w.w = cvt_pk_bf16(v[1][2], v[1][3]);
                __builtin_nontemporal_store(w, (u32x4*)(ACT + (((size_t)u.pm * (DFF / 64) + (size_t)(col0 >> 6)) * 256 + (size_t)(wr * 64 + fr + ai * 128 + m * 16)) * 64 + (col0 & 63)));
            }
        zero_acc(acc);
    }
};
template <int MODE> struct EpiRes {
    static constexpr bool PERM = true, RSTD = false, INIT_BASE = true;
    const float* basef; bf16_t* xb; float* outf; float* ssq;
    __device__ __forceinline__ void fill_rstd(LAS float*, int, int) const {}
    __device__ __forceinline__ static void expand(AccT& acc, int ai, int bj, int m, const u32x4 w) {
        acc[ai][bj][m][0] = (f32x4){bf_lo(w.x), bf_hi(w.x), bf_lo(w.y), bf_hi(w.y)}; acc[ai][bj][m][1] = (f32x4){bf_lo(w.z), bf_hi(w.z), bf_lo(w.w), bf_hi(w.w)};
    }
    __device__ __forceinline__ void load_group_f32(AccT& acc, int ai, int m, size_t off) const {
#pragma unroll
        for (int bj = 0; bj < 2; ++bj)
#pragma unroll
            for (int n = 0; n < 2; ++n) acc[ai][bj][m][n] = *(const f32x4*)(basef + off + bj * 128 + 4 * n);
    }
    __device__ __forceinline__ void init_acc(AccT& acc, const pg8::Unit& u, int wr, int wc, int fr, int fq) const {
        const int row0 = u.pm * 256 + wr * 64 + fr, col0 = u.pn * 256 + wc * 32 + 8 * fq;
#pragma unroll
        for (int ai = 0; ai < 2; ++ai)
#pragma unroll
            for (int m = 0; m < 4; ++m) {
                const size_t off = (size_t)(row0 + ai * 128 + m * 16) * D + col0;
                if (MODE == 0) load_group_f32(acc, ai, m, off);
                else {
#pragma unroll
                    for (int bj = 0; bj < 2; ++bj) expand(acc, ai, bj, m, *(const u32x4*)(xb + off + bj * 128));
                }
            }
    }
    __device__ __forceinline__ void finish_init(AccT& acc) const {
        __builtin_amdgcn_sched_barrier(0);
#pragma unroll
        for (int a = 0; a < 2; ++a)
#pragma unroll
            for (int b = 0; b < 2; ++b)
#pragma unroll
                for (int m = 0; m < 4; ++m)
#pragma unroll
                    for (int n = 0; n < 2; ++n) asm volatile("" : "+v"(acc[a][b][m][n]));
    }
    __device__ __forceinline__ void operator()(AccT& acc, const pg8::Unit& u, bool has_next, const pg8::Unit& nx, const LAS float*, int wr, int wc, int fr, int fq) const {
        const int row0 = u.pm * 256 + wr * 64 + fr, col0 = u.pn * 256 + wc * 32 + 8 * fq;
        const int nrow0 = nx.pm * 256 + wr * 64 + fr, ncol0 = nx.pn * 256 + wc * 32 + 8 * fq;
        u32x4 t[2][4][2];
        if (MODE != 0 && has_next) {
#pragma unroll
            for (int ai = 0; ai < 2; ++ai)
#pragma unroll
                for (int m = 0; m < 4; ++m) {
                    const size_t noff = (size_t)(nrow0 + ai * 128 + m * 16) * D + ncol0;
#pragma unroll
                    for (int bj = 0; bj < 2; ++bj) t[ai][m][bj] = *(const u32x4*)(xb + noff + bj * 128);
                }
            __builtin_amdgcn_sched_barrier(0);
        }
#pragma unroll
        for (int ai = 0; ai < 2; ++ai)
#pragma unroll
            for (int m = 0; m < 4; ++m) {
                const size_t off = (size_t)(row0 + ai * 128 + m * 16) * D + col0; float s = 0.f;
#pragma unroll
                for (int bj = 0; bj < 2; ++bj) {
                    const f32x4 o0 = acc[ai][bj][m][0], o1 = acc[ai][bj][m][1];
                    if (MODE == 2) { __builtin_nontemporal_store(o0, (f32x4*)(outf + off + bj * 128)); __builtin_nontemporal_store(o1, (f32x4*)(outf + off + bj * 128 + 4)); }
                    else {
                        s += ((o0[0] * o0[0] + o0[1] * o0[1]) + (o0[2] * o0[2] + o0[3] * o0[3])) + ((o1[0] * o1[0] + o1[1] * o1[1]) + (o1[2] * o1[2] + o1[3] * o1[3]));
                        u32x4 w; w.x = cvt_pk_bf16(o0[0], o0[1]); w.y = cvt_pk_bf16(o0[2], o0[3]); w.z = cvt_pk_bf16(o1[0], o1[1]); w.w = cvt_pk_bf16(o1[2], o1[3]);
                        *(u32x4*)(xb + off + bj * 128) = w;
                    }
                }
                if (MODE != 2) {
                    s += __shfl_xor(s, 16); s += __shfl_xor(s, 32);
                    if (fq == 0) ssq[(size_t)(row0 + ai * 128 + m * 16) * 16 + u.pn * 4 + wc] = s;
                }
                if (MODE == 0) { if (has_next) load_group_f32(acc, ai, m, (size_t)(nrow0 + ai * 128 + m * 16) * D + ncol0); }
            }
        if (MODE != 0 && has_next) {
            __builtin_amdgcn_sched_barrier(0);
#pragma unroll
            for (int ai = 0; ai < 2; ++ai)
#pragma unroll
                for (int m = 0; m < 4; ++m)
#pragma unroll
                    for (int bj = 0; bj < 2; ++bj) expand(acc, ai, bj, m, t[ai][m][bj]);
        }
    }
};
struct EpiQkv {
    static constexpr bool PERM = true, RSTD = true, INIT_BASE = false;
    bf16_t* Q; bf16_t* Kb; bf16_t* Vt; const float* ssq; const float* qg; const float* kg;
    __device__ __forceinline__ void init_acc(AccT& acc, const pg8::Unit&, int, int, int, int) const { zero_acc(acc); }
    __device__ __forceinline__ void fill_rstd(LAS float* dst, int pm, int tid) const { fill_rstd_tbl(ssq, dst, pm, tid); }
    __device__ __forceinline__ void operator()(AccT& acc, const pg8::Unit& u, bool, const pg8::Unit&, const LAS float* tbl, int wr, int wc, int fr, int fq) const {
        const int row0 = u.pm * 256 + wr * 64 + fr;
        float rs[2][4]; load_rstd(tbl, wr, fr, rs);
        if (u.pn < 5) {
            const bool isq = u.pn < 4;
            const float* gain = isq ? qg : kg; const float sc = isq ? 0.125f * LOG2E : 1.0f;
            bf16_t* dst = isq ? Q + (4 * u.pn + wc) * 64 : Kb + wc * 64; const int ld = isq ? 1024 : 256;
            f32x4 gv[2][2];
#pragma unroll
            for (int bj = 0; bj < 2; ++bj)
#pragma unroll
                for (int n = 0; n < 2; ++n) gv[bj][n] = *(const f32x4*)(gain + 32 * bj + 8 * fq + 4 * n) * sc;
#pragma unroll
            for (int ai = 0; ai < 2; ++ai)
#pragma unroll
                for (int m = 0; m < 4; ++m) {
                    const float r = rs[ai][m]; float ss = 0.f; f32x4 v[2][2];
#pragma unroll
                    for (int bj = 0; bj < 2; ++bj)
#pragma unroll
                        for (int n = 0; n < 2; ++n) { v[bj][n] = acc[ai][bj][m][n] * r; const f32x4 t = v[bj][n]; ss += (t[0] * t[0] + t[1] * t[1]) + (t[2] * t[2] + t[3] * t[3]); }
                    ss += __shfl_xor(ss, 16); ss += __shfl_xor(ss, 32);
                    const float rq = 1.0f / sqrtf(ss * (1.0f / 64.0f) + EPS);
                    bf16_t* rowp = dst + (size_t)(row0 + ai * 128 + m * 16) * ld + 8 * fq;
#pragma unroll
                    for (int bj = 0; bj < 2; ++bj) { const f32x4 o0 = v[bj][0] * rq * gv[bj][0], o1 = v[bj][1] * rq * gv[bj][1];
                        u32x4 w; w.x = cvt_pk_bf16(o0[0], o0[1]); w.y = cvt_pk_bf16(o0[2], o0[3]); w.z = cvt_pk_bf16(o1[0], o1[1]); w.w = cvt_pk_bf16(o1[2], o1[3]); *(u32x4*)(rowp + 32 * bj) = w; }
                }
        } else {
#pragma unroll
            for (int ai = 0; ai < 2; ++ai)
#pragma unroll
                for (int m = 0; m < 4; ++m) {
                    const int row = row0 + ai * 128 + m * 16; const float r = rs[ai][m];
                    bf16_t* p = Vt + ((size_t)((row >> 11) * 4 + wc) * 64 + 8 * fq) * SEQ + (row & (SEQ - 1));
#pragma unroll
                    for (int bj = 0; bj < 2; ++bj)
#pragma unroll
                        for (int n = 0; n < 2; ++n) { const f32x4 o = acc[ai][bj][m][n] * r;
#pragma unroll
                            for (int i = 0; i < 4; i += 2) { const unsigned w = cvt_pk_bf16(o[i], o[i + 1]); p[(size_t)(32 * bj + 4 * n + i) * SEQ] = (bf16_t)(w & 0xffffu); p[(size_t)(32 * bj + 4 * n + i + 1) * SEQ] = (bf16_t)(w >> 16); } }
                }
        }
        zero_acc(acc);
    }
};

constexpr size_t MiB = 1u << 20;
constexpr size_t WS_WIN = 1 * MiB, WS_WOUT = 7 * MiB, WS_GU0 = 9 * MiB, WS_DN0 = 20 * MiB, WS_WQKV = 26 * MiB, WS_WO = 29 * MiB, WS_GU1 = 31 * MiB, WS_DN1 = 42 * MiB;
constexpr size_t WS_SSQ = 48 * MiB;
constexpr size_t WS_XB = 64 * MiB;
constexpr size_t WS_R = 192 * MiB;
constexpr size_t WS_U = WS_R, WS_C = WS_R + 128 * MiB, WS_Z = WS_R + 256 * MiB;
constexpr size_t WS_ACT = WS_R;
constexpr size_t WS_Q = WS_R, WS_K = WS_R + 128 * MiB, WS_VT = WS_R + 160 * MiB, WS_ATT = WS_R + 192 * MiB;
constexpr size_t WS_END = WS_R + 384 * MiB;

constexpr int CW_OFF = 131072 + 2048;
constexpr int MISC_OFF = 147456 - 256;
constexpr int LDS_BYTES = 147456;
constexpr int NWAVES = 8;

__device__ __forceinline__ int map_row(int kind, int n0) {
    if (kind == 1) { if (n0 < 1024) return 256 * (n0 >> 7) + (n0 & 127); if (n0 < 2048) return 2048 + (n0 - 1024); const int n = n0 - 2048; return 256 * (n >> 7) + 128 + (n & 127); }
    if (kind == 2) { if (n0 < DFF) return 256 * (n0 >> 7) + (n0 & 127); const int n = n0 - DFF; return 256 * (n >> 7) + 128 + (n & 127); }
    if (kind == 3) { if (n0 < 1024) { const int hd = n0 >> 6, d0 = n0 & 63; return 256 * (hd >> 2) + 128 * (d0 >> 5) + 32 * (hd & 3); }
        const int n = n0 - 1024, t = n >> 8, n2 = n & 255, wc = n2 >> 6, d0 = n2 & 63; return 1024 + 256 * t + 128 * (d0 >> 5) + 32 * wc; }
    return n0;
}
__device__ __forceinline__ void p0_item(const float* W, int K, int N, bf16_t* WT, const float* gain, int kind, LAS float* scr, int item, int lane) {
    const int nblk = N / 32, kb = item / nblk, nb = item % nblk, k0 = 64 * kb, n0 = 32 * nb;
#pragma unroll 8
    for (int i = 0; i < 32; ++i) { const int kk = 2 * i + (lane >> 5); const float gsc = gain ? gain[k0 + kk] : 1.0f; scr[kk * 33 + (lane & 31)] = W[(size_t)(k0 + kk) * N + n0 + (lane & 31)] * gsc; }
    asm volatile("s_waitcnt lgkmcnt(0)" ::: "memory");
    const int c = lane & 7; const int r0 = map_row(kind, n0);
#pragma unroll
    for (int j = 0; j < 4; ++j) { const int n = (lane >> 3) + 8 * j; const LAS float* s = scr + (8 * c) * 33 + n;
        u32x4 o; o.x = cvt_pk_bf16(s[0 * 33], s[1 * 33]); o.y = cvt_pk_bf16(s[2 * 33], s[3 * 33]); o.z = cvt_pk_bf16(s[4 * 33], s[5 * 33]); o.w = cvt_pk_bf16(s[6 * 33], s[7 * 33]);
        *(u32x4*)(WT + (size_t)(r0 + n) * K + k0 + 8 * c) = o; }
    asm volatile("s_waitcnt lgkmcnt(0)" ::: "memory");
}
__device__ __forceinline__ float wave_sum(float v) {
#pragma unroll
    for (int o = 1; o < 64; o <<= 1) v += __shfl_xor(v, o);
    return v;
}

struct Args {
    const float* x; const float* conv_w_in; const float* conv_w; const float* conv_w_out; const float* w_qkv; const float* q_gain; const float* k_gain; const float* sinks;
    const float* w_o; const float* norm_mixer; const float* norm_ffn; const float* w_gu; const float* w_dn;
    float* out; unsigned char* ws; int ph_lo, ph_hi;
};

__device__ __forceinline__ void p0_prologue(const Args& a, LAS unsigned char* lds, int gw, int NGW, int lane, int wave) {
    LAS float* scr = (LAS float*)(lds + wave * 16384);
    unsigned char* ws = a.ws;
    constexpr int I_WIN = 16 * 96, I_SQ = 16 * 32, I_GU = 16 * 176, I_DN = 44 * 32, I_QKV = 16 * 48;
    constexpr int NITEMS = I_WIN + I_SQ + I_GU + I_DN + I_QKV + I_SQ + I_GU + I_DN;
    for (int it = gw; it < NITEMS; it += NGW) {
        int r = it;
        if (r < I_WIN) { p0_item(a.conv_w_in, D, 3 * D, (bf16_t*)(ws + WS_WIN), a.norm_mixer, 1, scr, r, lane); continue; } r -= I_WIN;
        if (r < I_SQ) { p0_item(a.conv_w_out, D, D, (bf16_t*)(ws + WS_WOUT), nullptr, 0, scr, r, lane); continue; } r -= I_SQ;
        if (r < I_GU) { p0_item(a.w_gu, D, 2 * DFF, (bf16_t*)(ws + WS_GU0), a.norm_ffn, 2, scr, r, lane); continue; } r -= I_GU;
        if (r < I_DN) { p0_item(a.w_dn, DFF, D, (bf16_t*)(ws + WS_DN0), nullptr, 0, scr, r, lane); continue; } r -= I_DN;
        if (r < I_QKV) { p0_item(a.w_qkv, D, NQKV, (bf16_t*)(ws + WS_WQKV), a.norm_mixer + D, 3, scr, r, lane); continue; } r -= I_QKV;
        if (r < I_SQ) { p0_item(a.w_o, D, D, (bf16_t*)(ws + WS_WO), nullptr, 0, scr, r, lane); continue; } r -= I_SQ;
        if (r < I_GU) { p0_item(a.w_gu + (size_t)D * 2 * DFF, D, 2 * DFF, (bf16_t*)(ws + WS_GU1), a.norm_ffn + D, 2, scr, r, lane); continue; } r -= I_GU;
        p0_item(a.w_dn + (size_t)DFF * D, DFF, D, (bf16_t*)(ws + WS_DN1), nullptr, 0, scr, r, lane);
    }
    bf16_t* xb = (bf16_t*)(ws + WS_XB); float* ssq = (float*)(ws + WS_SSQ);
    for (int m0 = gw; m0 < M; m0 += 2 * NGW) {
        const int m1 = m0 + NGW; const bool two = m1 < M;
        f32x4 v[2][4];
#pragma unroll
        for (int q = 0; q < 2; ++q) { const int m = q ? (two ? m1 : m0) : m0; const f32x4* xr = (const f32x4*)(a.x + (size_t)m * D) + 2 * lane;
#pragma unroll
            for (int j = 0; j < 2; ++j) { v[q][2 * j] = xr[128 * j]; v[q][2 * j + 1] = xr[128 * j + 1]; } }
#pragma unroll
        for (int q = 0; q < 2; ++q) {
            if (q == 1 && !two) break;
            const int m = q ? m1 : m0; float s = 0.f;
#pragma unroll
            for (int j = 0; j < 4; ++j) s += (v[q][j][0] * v[q][j][0] + v[q][j][1] * v[q][j][1]) + (v[q][j][2] * v[q][j][2] + v[q][j][3] * v[q][j][3]);
            s = wave_sum(s);
            u32x4* o16 = (u32x4*)(xb + (size_t)m * D) + lane;
#pragma unroll
            for (int j = 0; j < 2; ++j) { u32x4 w; w.x = cvt_pk_bf16(v[q][2 * j][0], v[q][2 * j][1]); w.y = cvt_pk_bf16(v[q][2 * j][2], v[q][2 * j][3]); w.z = cvt_pk_bf16(v[q][2 * j + 1][0], v[q][2 * j + 1][1]); w.w = cvt_pk_bf16(v[q][2 * j + 1][2], v[q][2 * j + 1][3]); o16[64 * j] = w; }
            if (lane < 16) ssq[(size_t)m * 16 + lane] = (lane == 0) ? s : 0.f;
        }
    }
}

constexpr int AT_KS = 0, AT_KSTR = 144, AT_VS = 256 * AT_KSTR, AT_VSTR = 520, AT_L = AT_VS + 64 * AT_VSTR, AT_STG = AT_L + 1024;
__device__ __forceinline__ void attn_phase(const Args& a, LAS unsigned char* lds, int cu, int G, int wid) {
    const bf16_t* Q = (const bf16_t*)(a.ws + WS_Q); const bf16_t* Kb = (const bf16_t*)(a.ws + WS_K); const bf16_t* Vt = (const bf16_t*)(a.ws + WS_VT); bf16_t* O = (bf16_t*)(a.ws + WS_ATT);
    const int lane = lane_id(), tid = wid * 64 + lane, r = lane & 31, h = lane >> 5;
    LAS float* lw = (LAS float*)(lds + AT_L) + wid * 32;
    bf16x8 qn[4];
    if (cu < 32 * 16 * 4) { const int kvh_ = cu & 3, nb_ = (cu >> 2) & 15, b_ = cu >> 6; const size_t qt_ = (size_t)b_ * SEQ + nb_ * 128 + 32 * (2 * (wid & 1));
#pragma unroll
      for (int s = 0; s < 4; ++s) qn[s] = *(const bf16x8*)(Q + (qt_ + r) * D + (4 * kvh_ + (wid >> 1)) * 64 + 16 * s + 8 * h); }
    for (int ui = cu; ui < 32 * 16 * 4; ui += G) {
        const int kvh = ui & 3, nb = (ui >> 2) & 15, b = ui >> 6;
        const int tok0 = b * SEQ + (nb - 1) * 128;
#pragma unroll
        for (int i = 0; i < 4; ++i) {
            const int c = tid + 512 * i, row = c >> 3, chk = c & 7;
            u32x4 v = (u32x4){0u, 0u, 0u, 0u};
            if (nb > 0 || row >= 128) v = *(const u32x4*)(Kb + (size_t)(tok0 + row) * 256 + kvh * 64 + chk * 8);
            *(LAS u32x4*)(lds + AT_KS + row * AT_KSTR + chk * 16) = v;
        }
#pragma unroll
        for (int i = 0; i < 4; ++i) {
            const int c = tid + 512 * i, d = c >> 5, chk = c & 31;
            u32x4 v = (u32x4){0u, 0u, 0u, 0u};
            if (nb > 0 || chk >= 16) v = *(const u32x4*)(Vt + ((size_t)(b * 4 + kvh) * 64 + d) * SEQ + (nb - 1) * 128 + chk * 8);
            LAS u32x2* p = (LAS u32x2*)(lds + AT_VS + d * AT_VSTR + chk * 16);
            p[0] = (u32x2){v.x, v.y}; p[1] = (u32x2){v.z, v.w};
        }
        __syncthreads();
        const int g = wid >> 1, hq = 4 * kvh + g;
        const float slope2 = exp2f(-0.5f * (float)(hq + 1)) * LOG2E, sink2 = a.sinks[hq] * LOG2E;
        for (int sbi = 0; sbi < 2; ++sbi) {
            const int sb = 2 * (wid & 1) + sbi;
            const size_t qtok = (size_t)b * SEQ + nb * 128 + 32 * sb;
            bf16x8 qf[4];
#pragma unroll
            for (int s = 0; s < 4; ++s) qf[s] = qn[s];
            {
                const int nu = (sbi == 0) ? ui : ui + G;
                if (nu < 32 * 16 * 4) { const int kvh_ = nu & 3, nb_ = (nu >> 2) & 15, b_ = nu >> 6; const size_t qt_ = (size_t)b_ * SEQ + nb_ * 128 + 32 * (2 * (wid & 1) + (sbi ^ 1));
#pragma unroll
                    for (int s = 0; s < 4; ++s) qn[s] = *(const bf16x8*)(Q + (qt_ + r) * D + (4 * kvh_ + (wid >> 1)) * 64 + 16 * s + 8 * h); }
            }
            f32x16 st[5];
#pragma unroll
            for (int kt = 0; kt < 5; ++kt) {
                const int kb = 32 * (sb + kt);
                st[kt] = (f32x16){0.f, 0.f, 0.f, 0.f, 0.f, 0.f, 0.f, 0.f, 0.f, 0.f, 0.f, 0.f, 0.f, 0.f, 0.f, 0.f};
#pragma unroll
                for (int s = 0; s < 4; ++s) {
                    const bf16x8 kf = *(const LAS bf16x8*)(lds + AT_KS + (kb + r) * AT_KSTR + (16 * s + 8 * h) * 2);
                    st[kt] = __builtin_amdgcn_mfma_f32_32x32x16_bf16(kf, qf[s], st[kt], 0, 0, 0);
                }
                __builtin_amdgcn_sched_barrier(0);
            }
            int rr = r, hh = h; asm volatile("" : "+v"(rr), "+v"(hh));
            const int basei = rr + 128 - 4 * hh; const float nsb = -slope2 * (float)basei;
            float mx = sink2;
#pragma unroll
            for (int kt = 0; kt < 5; ++kt) {
                const bool tv = (nb > 0) || (sb + kt >= 4);
#pragma unroll
                for (int i = 0; i < 16; ++i) {
                    const int c = 32 * kt + (i & 3) + 8 * (i >> 2);
                    float v = (st[kt][i] + slope2 * (float)c) + nsb;
                    bool valid = tv;
                    if (kt == 0) valid = valid && (basei - c < 128);
                    if (kt == 4) valid = valid && (basei - c >= 0);
                    v = valid ? v : -INFINITY;
                    st[kt][i] = v; mx = fmaxf(mx, v);
                }
            }
            mx = fmaxf(mx, __shfl_xor(mx, 32));
            float l = 0.f;
#pragma unroll
            for (int kt = 0; kt < 5; ++kt)
#pragma unroll
                for (int i = 0; i < 16; ++i) { const float p = __builtin_amdgcn_exp2f(st[kt][i] - mx); st[kt][i] = p; l += p; }
            l += __shfl_xor(l, 32);
            l += __builtin_amdgcn_exp2f(sink2 - mx);
            if (h == 0) lw[r] = l;
            f32x16 o[2];
            o[0] = (f32x16){0.f, 0.f, 0.f, 0.f, 0.f, 0.f, 0.f, 0.f, 0.f, 0.f, 0.f, 0.f, 0.f, 0.f, 0.f, 0.f}; o[1] = o[0];
#pragma unroll
            for (int kt = 0; kt < 5; ++kt)
#pragma unroll
                for (int s2 = 0; s2 < 2; ++s2) {
                    u32x4 pw; pw.x = cvt_pk_bf16(st[kt][8 * s2 + 0], st[kt][8 * s2 + 1]); pw.y = cvt_pk_bf16(st[kt][8 * s2 + 2], st[kt][8 * s2 + 3]);
                    pw.z = cvt_pk_bf16(st[kt][8 * s2 + 4], st[kt][8 * s2 + 5]); pw.w = cvt_pk_bf16(st[kt][8 * s2 + 6], st[kt][8 * s2 + 7]);
                    const bf16x8 pa = __builtin_bit_cast(bf16x8, pw);
                    const int kb = 32 * (sb + kt) + 16 * s2 + 4 * h;
#pragma unroll
                    for (int c = 0; c < 2; ++c) {
                        const LAS unsigned char* vp = lds + AT_VS + (32 * c + r) * AT_VSTR + kb * 2;
                        const u32x2 lo = *(const LAS u32x2*)vp, hi = *(const LAS u32x2*)(vp + 16);
                        const u32x4 vw = (u32x4){lo.x, lo.y, hi.x, hi.y};
                        o[c] = __builtin_amdgcn_mfma_f32_32x32x16_bf16(pa, __builtin_bit_cast(bf16x8, vw), o[c], 0, 0, 0);
                    }
                    __builtin_amdgcn_sched_barrier(0);
                }
            asm volatile("s_waitcnt lgkmcnt(0)" ::: "memory");
            LAS bf16_t* stg = (LAS bf16_t*)(lds + AT_STG) + wid * 2048;
#pragma unroll
            for (int i = 0; i < 16; ++i) {
                const int qr = (i & 3) + 8 * (i >> 2) + 4 * h;
                const float li = __builtin_amdgcn_rcpf(lw[qr]);
                const unsigned w = cvt_pk_bf16(o[0][i] * li, o[1][i] * li);
                stg[qr * 64 + r] = (bf16_t)(w & 0xffffu); stg[qr * 64 + 32 + r] = (bf16_t)(w >> 16);
            }
            asm volatile("s_waitcnt lgkmcnt(0)" ::: "memory");
#pragma unroll
            for (int j = 0; j < 4; ++j) {
                const int row = j * 8 + (lane >> 3), ch = lane & 7;
                const u32x4 v = *(const LAS u32x4*)(stg + row * 64 + ch * 8);
                *(u32x4*)(O + (qtok + row) * D + hq * 64 + ch * 8) = v;
            }
            asm volatile("s_waitcnt lgkmcnt(0)" ::: "memory");
        }
        __syncthreads();
    }
}

#define XB_TMO      128
#define XB_XCNT(j)  (256  + 64 * (j))
#define XB_XSUB(j)  (1280 + 64 * (j))
#define XB_XGEN(j)  (2304 + 64 * (j))
#define XB_TOP      3328
#define XB_TOPGEN   3392
#define XCD_BAR_WORDS 3456
#define XB_SPIN_CAP (1u << 18)

__device__ __forceinline__ unsigned xb_ld(unsigned* p)              { return __hip_atomic_load(p, __ATOMIC_RELAXED, __HIP_MEMORY_SCOPE_AGENT); }
__device__ __forceinline__ unsigned xb_add(unsigned* p, unsigned v) { return __hip_atomic_fetch_add(p, v, __ATOMIC_RELAXED, __HIP_MEMORY_SCOPE_AGENT); }
__device__ __forceinline__ unsigned xb_xcc_id() { return (unsigned)__builtin_amdgcn_s_getreg((3 << 11) | 20) & 0xFu; }
#define XB_SPIN(cond, bar) do { unsigned _sp = 0; while (cond) { __builtin_amdgcn_s_sleep(1); \
    if ((++_sp & 255u) == 0u) { if (xb_ld(&(bar)[XB_TMO])) break; if (_sp > XB_SPIN_CAP) { atomicAdd(&(bar)[XB_TMO], 1u); break; } } } } while (0)

struct XcdBarrier {
    unsigned* bar; unsigned x; unsigned w;
    volatile LAS unsigned* st;
};

__device__ __forceinline__ XcdBarrier xcd_barrier_post(unsigned* bar, volatile LAS unsigned* st) {
    XcdBarrier b; b.bar = bar; b.x = xb_xcc_id(); b.st = st; b.w = 0u;
    if (threadIdx.x == 0) (void)xb_add(&bar[XB_XCNT(b.x)], 1u);
    return b;
}
__device__ __forceinline__ void xcd_barrier_complete(unsigned* bar, unsigned x, unsigned& nloc, unsigned& nx) {
    const unsigned G = gridDim.x * gridDim.y * gridDim.z;
    unsigned sum, cnt, mine, sp = 0u;
    for (;;) {
        sum = 0u; cnt = 0u; mine = 0u;
#pragma unroll
        for (unsigned j = 0; j < 16; ++j) { const unsigned c = xb_ld(&bar[XB_XCNT(j)]); sum += c; cnt += (c > 0u) ? 1u : 0u; mine = (j == x) ? c : mine; }
        if (sum == G) break;
        __builtin_amdgcn_s_sleep(1);
        if ((++sp & 255u) == 0u) { if (xb_ld(&bar[XB_TMO])) break; if (sp > XB_SPIN_CAP) { atomicAdd(&bar[XB_TMO], 1u); break; } }
    }
    nloc = mine > 0u ? mine : 1u; nx = cnt > 0u ? cnt : 1u;
}

__device__ __forceinline__ void xcd_barrier(const XcdBarrier& b) {
    asm volatile("s_waitcnt vmcnt(0)" ::: "memory");
    __syncthreads();
    if (b.w == 0u && lane_id() == 0) {
        unsigned* bar = b.bar;
        __builtin_amdgcn_s_waitcnt(0);
        unsigned nloc = b.st[0], nx = b.st[1];
        if (nloc == 0u) { xcd_barrier_complete(bar, b.x, nloc, nx); b.st[0] = nloc; b.st[1] = nx; }
        const unsigned old = xb_add(&bar[XB_XSUB(b.x)], 1u);
        const unsigned gen = old / nloc;
        if (old + 1u == (gen + 1u) * nloc) {
            __builtin_amdgcn_fence(__ATOMIC_RELEASE, "agent");
            asm volatile("s_waitcnt vmcnt(0)" ::: "memory");
            const unsigned og = xb_add(&bar[XB_TOP], 1u);
            const unsigned tg = og / nx;
            if (og + 1u == (tg + 1u) * nx) xb_add(&bar[XB_TOPGEN], 1u);
            else XB_SPIN(xb_ld(&bar[XB_TOPGEN]) == tg, bar);
            __builtin_amdgcn_fence(__ATOMIC_ACQUIRE, "agent");
            xb_add(&bar[XB_XGEN(b.x)], 1u);
            asm volatile("s_waitcnt vmcnt(0)" ::: "memory");
        } else {
            XB_SPIN(xb_ld(&bar[XB_XGEN(b.x)]) == gen, bar);
            __builtin_amdgcn_fence(__ATOMIC_ACQUIRE, "agent");
            asm volatile("s_waitcnt vmcnt(0)" ::: "memory");
        }
    }
    __syncthreads();
}


__global__ void __launch_bounds__(NWAVES * 64, 2) fwd_kernel(Args a) {
    extern __shared__ __attribute__((aligned(16))) unsigned char lds_raw[];
    LAS unsigned char* lds = (LAS unsigned char*)lds_raw;
    const int wave = __builtin_amdgcn_readfirstlane(threadIdx.x >> 6);
    const int G = gridDim.x, bx = blockIdx.x;
    unsigned char* ws = a.ws;
    float* ssq = (float*)(ws + WS_SSQ); bf16_t* xb = (bf16_t*)(ws + WS_XB);
    volatile LAS unsigned* misc = (volatile LAS unsigned*)(lds + MISC_OFF);
    if (threadIdx.x < 16) misc[threadIdx.x] = 0u;
    __syncthreads();
    XcdBarrier xbar = xcd_barrier_post((unsigned*)ws, misc); xbar.w = (unsigned)wave;
#define SEAM() xcd_barrier(xbar)
    if (a.ph_hi > 1000) cg::this_grid().sync();
    { const int vcu = (G % 8 == 0) ? (bx % 8) * (G / 8) + bx / 8 : bx; p0_prologue(a, lds, vcu * NWAVES + wave, G * NWAVES, lane_id(), wave); }
    SEAM();
    {
        pg8::Gemm g{xb, (const bf16_t*)(ws + WS_WIN), M, 2 * D, D}; pg8::StaticOrder S; S.init(M, 2 * D, G, bx);
        EpiU E{(bf16_t*)(ws + WS_U), ssq};
        pg8::gemm_phase<EpiU>(lds, g, S, E, wave);
    }
    SEAM();
    {
        LAS float* cw = (LAS float*)(lds + CW_OFF);
        for (int i = wave * 64 + lane_id(); i < 3 * D; i += NWAVES * 64) cw[i] = a.conv_w[i];
        __syncthreads();
        pg8::Gemm g{xb, (const bf16_t*)(ws + WS_WIN) + (size_t)2 * D * D, M, D, D}; pg8::StaticOrder S; S.init(M, D, G, bx);
        EpiCz E{(const bf16_t*)(ws + WS_U), (bf16_t*)(ws + WS_Z), ssq, cw};
        pg8::gemm_phase<EpiCz>(lds, g, S, E, wave);
    }
    SEAM();
    {
        pg8::Gemm g{(const bf16_t*)(ws + WS_Z), (const bf16_t*)(ws + WS_WOUT), M, D, D}; pg8::StaticOrder S; S.init(M, D, G, bx);
        EpiRes<1> E{nullptr, xb, nullptr, ssq};
        pg8::gemm_phase<EpiRes<1>, false>(lds, g, S, E, wave);
    }
    SEAM();
    {
        pg8::Gemm g{xb, (const bf16_t*)(ws + WS_GU0), M, 2 * DFF, D}; pg8::StaticOrder S; S.init(M, 2 * DFF, G, bx);
        EpiGu E{(bf16_t*)(ws + WS_ACT), ssq};
        pg8::gemm_phase<EpiGu>(lds, g, S, E, wave);
    }
    SEAM();
    {
        pg8::Gemm g{(const bf16_t*)(ws + WS_ACT), (const bf16_t*)(ws + WS_DN0), M, D, DFF}; pg8::StaticOrder S; S.init(M, D, G, bx);
        EpiRes<1> E{nullptr, xb, nullptr, ssq};
        pg8::gemm_phase<EpiRes<1>, false, true>(lds, g, S, E, wave);
    }
    SEAM();
    {
        pg8::Gemm g{xb, (const bf16_t*)(ws + WS_WQKV), M, NQKV, D}; pg8::StaticOrder S; S.init(M, NQKV, G, bx);
        EpiQkv E{(bf16_t*)(ws + WS_Q), (bf16_t*)(ws + WS_K), (bf16_t*)(ws + WS_VT), ssq, a.q_gain, a.k_gain};
        pg8::gemm_phase<EpiQkv>(lds, g, S, E, wave);
    }
    SEAM();
    attn_phase(a, lds, bx, G, wave);
    SEAM();
    {
        pg8::Gemm g{(const bf16_t*)(ws + WS_ATT), (const bf16_t*)(ws + WS_WO), M, D, D}; pg8::StaticOrder S; S.init(M, D, G, bx);
        EpiRes<1> E{nullptr, xb, nullptr, ssq};
        pg8::gemm_phase<EpiRes<1>, false>(lds, g, S, E, wave);
    }
    SEAM();
    {
        pg8::Gemm g{xb, (const bf16_t*)(ws + WS_GU1), M, 2 * DFF, D}; pg8::StaticOrder S; S.init(M, 2 * DFF, G, bx);
        EpiGu E{(bf16_t*)(ws + WS_ACT), ssq};
        pg8::gemm_phase<EpiGu>(lds, g, S, E, wave);
    }
    SEAM();
    {
        pg8::Gemm g{(const bf16_t*)(ws + WS_ACT), (const bf16_t*)(ws + WS_DN1), M, D, DFF}; pg8::StaticOrder S; S.init(M, D, G, bx);
        EpiRes<2> E{nullptr, xb, a.out, nullptr};
        pg8::gemm_phase<EpiRes<2>, false, true>(lds, g, S, E, wave);
    }
#undef SEAM
}

extern "C" void kernel_launch(void* const* d_in, const int* in_sizes, int n_in, void* d_out, int out_size, void* d_ws, size_t ws_size, hipStream_t stream) {
    static int grid = 0;
    if (grid == 0) {
        if (n_in != 13 || in_sizes[0] != M * D || out_size != M * D || ws_size < WS_END) { fprintf(stderr, "kernel_launch: unexpected shapes (n_in %d, in0 %d, out %d, ws %zu)\n", n_in, n_in > 0 ? in_sizes[0] : -1, out_size, ws_size); grid = -1; return; }
        int dev = 0, cus = 0, per_cu = 0;
        if (hipGetDevice(&dev) != hipSuccess || hipDeviceGetAttribute(&cus, hipDeviceAttributeMultiprocessorCount, dev) != hipSuccess) { grid = -1; return; }
        if (hipFuncSetAttribute((const void*)fwd_kernel, hipFuncAttributeMaxDynamicSharedMemorySize, LDS_BYTES) != hipSuccess) { fprintf(stderr, "kernel_launch: hipFuncSetAttribute failed\n"); grid = -1; return; }
        if (hipOccupancyMaxActiveBlocksPerMultiprocessor(&per_cu, (const void*)fwd_kernel, NWAVES * 64, LDS_BYTES) != hipSuccess || per_cu < 1) { fprintf(stderr, "kernel_launch: occupancy query gave %d\n", per_cu); per_cu = 1; }
        (void)hipGetLastError();
        grid = cus * 1;
    }
    if (grid < 0) return;
    if (hipMemsetAsync(d_ws, 0, 16384, stream) != hipSuccess) { fprintf(stderr, "kernel_launch: hipMemsetAsync failed\n"); return; }
    Args a{};
    a.x = (const float*)d_in[0]; a.conv_w_in = (const float*)d_in[1]; a.conv_w = (const float*)d_in[2]; a.conv_w_out = (const float*)d_in[3];
    a.w_qkv = (const float*)d_in[4]; a.q_gain = (const float*)d_in[5]; a.k_gain = (const float*)d_in[6]; a.sinks = (const float*)d_in[7];
    a.w_o = (const float*)d_in[8]; a.norm_mixer = (const float*)d_in[9]; a.norm_ffn = (const float*)d_in[10]; a.w_gu = (const float*)d_in[11]; a.w_dn = (const float*)d_in[12];
    a.out = (float*)d_out; a.ws = (unsigned char*)d_ws;
    a.ph_lo = 0; a.ph_hi = 11;
    void* args[] = {&a};
    hipError_t e = hipLaunchCooperativeKernel((const void*)fwd_kernel, dim3(grid), dim3(NWAVES * 64), args, LDS_BYTES, stream);
    if (e != hipSuccess) fprintf(stderr, "cooperative launch failed: %s (grid %d)\n", hipGetErrorString(e), grid);
}
```

```cpp
#include <hip/hip_runtime.h>
#include <hip/hip_cooperative_groups.h>
#include <cstdio>
#include <cstdint>
namespace cg = cooperative_groups;


#define LAS __attribute__((address_space(3)))
typedef unsigned short bf16_t;
typedef short bf16x8 __attribute__((ext_vector_type(8)));
typedef short s16x4 __attribute__((ext_vector_type(4)));
typedef float f32x4 __attribute__((ext_vector_type(4)));
typedef float f32x16 __attribute__((ext_vector_type(16)));
typedef unsigned u32x4 __attribute__((ext_vector_type(4)));
typedef unsigned u32x2 __attribute__((ext_vector_type(2)));

constexpr int M = 65536, D = 1024, DFF = 2816, SEQ = 2048, NQKV = 1536;
constexpr float EPS = 1e-6f, LOG2E = 1.4426950408889634f;

__device__ __forceinline__ unsigned cvt_pk_bf16(float lo, float hi) { unsigned r; asm volatile("v_cvt_pk_bf16_f32 %0, %1, %2" : "=v"(r) : "v"(lo), "v"(hi)); return r; }
__device__ __forceinline__ int lane_id() { int l; asm volatile("v_mbcnt_lo_u32_b32 %0, -1, 0\n\tv_mbcnt_hi_u32_b32 %0, -1, %0" : "=v"(l)); return l; }
__device__ __forceinline__ float bf_lo(unsigned w) { return __builtin_bit_cast(float, w << 16); }
__device__ __forceinline__ float bf_hi(unsigned w) { return __builtin_bit_cast(float, w & 0xffff0000u); }

namespace pg8 {
constexpr int BM = 256, BK = 64, HALF = 128, HTB = HALF * BK * 2, STAGE_BYTES = 8 * HTB, NXCD = 8, WGM = 8;
__host__ __device__ __forceinline__ int lds_byte(int r, int c) { const int st = (r >> 4) * 2 + (c >> 5), rr = r & 15, cc = c & 31, ob = rr * 64 + cc * 2; return st * 1024 + (ob ^ (((ob >> 9) & 1) << 5)); }
__host__ __device__ __forceinline__ void stage_rc(int b, int& R, int& C) { const int st = b / 1024, sb = b % 1024, swz = sb ^ (((sb >> 9) & 1) << 5); R = (st >> 1) * 16 + swz / 64; C = (st & 1) * 32 + (swz % 64) / 2; }
__host__ __device__ __forceinline__ int perm32(int rho) { const int n = rho >> 4, i = rho & 15; return 8 * (i >> 2) + 4 * n + (i & 3); }

struct Unit { int pm, pn; };
struct Gemm { const bf16_t* A; const bf16_t* Bt; int M, N, K; };

struct StaticOrder {
    int nM, nN, nwg, G, c;
    __host__ __device__ void init(int M_, int N_, int G_, int c_) { nM = M_ / BM; nN = N_ / BM; nwg = nM * nN; G = G_; c = c_; }
    __host__ __device__ bool next(int i, Unit& u) const {
        const long L = (long)i * G + c; if (L >= nwg) return false;
        int wgid = (int)L; { const int q = nwg / NXCD, r = nwg % NXCD, xcd = wgid % NXCD, off = wgid / NXCD; wgid = (xcd < r ? xcd * (q + 1) : r * (q + 1) + (xcd - r) * q) + off; }
        const int nig = WGM * nN, gid = wgid / nig, fm = gid * WGM, gsz = (nM - fm) < WGM ? (nM - fm) : WGM;
        u.pm = fm + ((wgid % nig) % gsz); u.pn = (wgid % nig) / gsz; return true;
    }
};

template <class Epi, bool ALIGN_EPI = true>
__device__ __forceinline__ void gemm_phase(LAS unsigned char* lds, const Gemm g, const StaticOrder& S, const Epi& E, int wid) {
    const int lane = lane_id(), tid = wid * 64 + lane, wr = wid >> 2, wc = wid & 3, fr = lane & 15, fq = lane >> 4;
    const int K = g.K, nt = K / BK;
    unsigned voffA[2], voffB[2];
#pragma unroll
    for (int i = 0; i < 2; ++i) { int R, C; stage_rc(tid * 16 + i * 8192, R, C); const int Rb = Epi::PERM ? ((R & ~31) + perm32(R & 31)) : R;
        voffA[i] = (unsigned)(R * K + C) * 2u; voffB[i] = (unsigned)(Rb * K + C) * 2u; }
    const size_t kstep = (size_t)(BK * 2);
    const size_t hstep = (size_t)HALF * K * 2;
    const size_t tstep = 2 * hstep;
    const unsigned ldsw = (unsigned)wid * 1024u;
    const int aoff = lds_byte(wr * 64 + fr, fq * 8), boff = lds_byte(wc * 32 + fr, fq * 8);
#define PG8_SA(b, h) (((b) * 2 + (h)) * HTB)
#define PG8_SB(b, h) ((4 + (b) * 2 + (h)) * HTB)
#define PG8_STAGE(bufoff, gbase, voff) do { _Pragma("unroll") for (int _i = 0; _i < 2; ++_i) \
        __builtin_amdgcn_global_load_lds((const unsigned*)((const char*)(gbase) + (voff)[_i]), (LAS unsigned*)(lds + (bufoff) + ldsw + _i * 8192), 16, 0, 0); } while (0)
#define PG8_LDA(dst, b, h) do { _Pragma("unroll") for (int m = 0; m < 4; ++m) _Pragma("unroll") for (int k = 0; k < 2; ++k) dst[m][k] = *(const LAS bf16x8*)(lds + PG8_SA(b, h) + aoff + m * 2048 + k * 1024); } while (0)
#define PG8_LDB(dst, b, h) do { _Pragma("unroll") for (int n = 0; n < 2; ++n) _Pragma("unroll") for (int k = 0; k < 2; ++k) dst[n][k] = *(const LAS bf16x8*)(lds + PG8_SB(b, h) + boff + n * 2048 + k * 1024); } while (0)
#define PG8_MMA(ai, bj, At, Bt) do { __builtin_amdgcn_s_setprio(1); _Pragma("unroll") for (int m = 0; m < 4; ++m) _Pragma("unroll") for (int n = 0; n < 2; ++n) _Pragma("unroll") for (int k = 0; k < 2; ++k) \
        acc[ai][bj][m][n] = __builtin_amdgcn_mfma_f32_16x16x32_bf16(Bt[n][k], At[m][k], acc[ai][bj][m][n], 0, 0, 0); __builtin_amdgcn_s_setprio(0); } while (0)
#define PG8_WAIT_V(n) asm volatile("s_waitcnt vmcnt(" #n ")" ::: "memory")
#define PG8_WAIT_L(n) asm volatile("s_waitcnt lgkmcnt(" #n ")" ::: "memory")
#define PG8_BAR __builtin_amdgcn_s_barrier()
#define PG8_SCHED __builtin_amdgcn_sched_barrier(0)
    Unit cur, nxt; int ui = 0;
    if (!S.next(0, cur)) return;
    f32x4 acc[2][2][4][2];
    E.init_acc(acc, cur, wr, wc, fr, fq);
    int rpm = -1, rbuf = 0;
    bf16x8 At[4][2], B0[2][2], B1[2][2];
    const char* cA = (const char*)g.A + (size_t)cur.pm * tstep; const char* cB = (const char*)g.Bt + (size_t)cur.pn * tstep;
    PG8_STAGE(PG8_SB(0, 0), cB, voffB); PG8_STAGE(PG8_SB(0, 1), cB + hstep, voffB); PG8_STAGE(PG8_SA(0, 0), cA, voffA); PG8_STAGE(PG8_SA(0, 1), cA + hstep, voffA);
    if (wr == 1) PG8_BAR;
    PG8_WAIT_V(2); PG8_BAR;
    PG8_STAGE(PG8_SB(1, 0), cB + kstep, voffB); PG8_STAGE(PG8_SA(1, 0), cA + kstep, voffA); PG8_STAGE(PG8_SB(1, 1), cB + hstep + kstep, voffB);
    PG8_WAIT_V(6); PG8_BAR;
    for (;;) {
        const bool has_next = S.next(ui + 1, nxt);
        const char* nA = has_next ? (const char*)g.A + (size_t)nxt.pm * tstep : cA; const char* nB = has_next ? (const char*)g.Bt + (size_t)nxt.pn * tstep : cB;
        if constexpr (Epi::RSTD) { if (cur.pm != rpm) { rbuf ^= 1; rpm = cur.pm; E.fill_rstd((LAS float*)(lds + STAGE_BYTES) + rbuf * 256, cur.pm, tid); } }
        if constexpr (Epi::INIT_BASE) E.finish_init(acc);
        for (int t = 0; t < nt; t += 2) {
            const bool last = (t == nt - 2);
            const char* a1 = cA + (size_t)(t + 1) * kstep;
            const char* a2 = last ? nA : cA + (size_t)(t + 2) * kstep; const char* b2 = last ? nB : cB + (size_t)(t + 2) * kstep;
            const char* a3 = a2 + kstep; const char* b3 = b2 + kstep;
            PG8_LDB(B0, 0, 0); PG8_LDB(B1, 0, 1); PG8_SCHED; PG8_LDA(At, 0, 0); PG8_STAGE(PG8_SA(1, 1), a1 + hstep, voffA);
            PG8_WAIT_V(8); PG8_WAIT_L(0); PG8_BAR; PG8_MMA(0, 0, At, B0); PG8_MMA(0, 1, At, B1); PG8_BAR; PG8_SCHED;
            PG8_LDA(At, 0, 1); PG8_STAGE(PG8_SB(0, 0), b2, voffB); PG8_STAGE(PG8_SB(0, 1), b2 + hstep, voffB); PG8_STAGE(PG8_SA(0, 0), a2, voffA);
            PG8_WAIT_V(8); PG8_WAIT_L(0); PG8_BAR; PG8_MMA(1, 0, At, B0); PG8_MMA(1, 1, At, B1); PG8_BAR; PG8_SCHED;
            PG8_LDB(B0, 1, 0); PG8_LDB(B1, 1, 1); PG8_SCHED; PG8_LDA(At, 1, 0); PG8_STAGE(PG8_SA(0, 1), a2 + hstep, voffA);
            PG8_WAIT_V(8); PG8_WAIT_L(0); PG8_BAR; PG8_MMA(0, 0, At, B0); PG8_MMA(0, 1, At, B1); PG8_BAR; PG8_SCHED;
            PG8_LDA(At, 1, 1); PG8_STAGE(PG8_SB(1, 0), b3, voffB); PG8_STAGE(PG8_SB(1, 1), b3 + hstep, voffB); PG8_STAGE(PG8_SA(1, 0), a3, voffA);
            PG8_WAIT_V(8); PG8_WAIT_L(0); PG8_BAR; PG8_MMA(1, 0, At, B0); PG8_MMA(1, 1, At, B1); PG8_BAR; PG8_SCHED;
        }
        if constexpr (ALIGN_EPI) { if (wr == 0) PG8_BAR; }
        E(acc, cur, has_next, nxt, (const LAS float*)(lds + STAGE_BYTES) + rbuf * 256, wr, wc, fr, fq);
        if (!has_next) break;
        cur = nxt; cA = nA; cB = nB; ++ui;
        if constexpr (ALIGN_EPI) { if (wr == 1) PG8_BAR; }
    }
    PG8_WAIT_V(0);
    if constexpr (!ALIGN_EPI) { if (wr == 0) PG8_BAR; }
    PG8_BAR;
#undef PG8_SA
#undef PG8_SB
#undef PG8_STAGE
#undef PG8_LDA
#undef PG8_LDB
#undef PG8_MMA
#undef PG8_WAIT_V
#undef PG8_WAIT_L
#undef PG8_BAR
#undef PG8_SCHED
}
}

typedef f32x4 AccT[2][2][4][2];
__device__ __forceinline__ void zero_acc(AccT& acc) {
#pragma unroll
    for (int a = 0; a < 2; ++a)
#pragma unroll
        for (int b = 0; b < 2; ++b)
#pragma unroll
            for (int m = 0; m < 4; ++m)
#pragma unroll
                for (int n = 0; n < 2; ++n) acc[a][b][m][n] = (f32x4){0.f, 0.f, 0.f, 0.f};
}
__device__ __forceinline__ void fill_rstd_tbl(const float* ssq, LAS float* dst, int pm, int tid) {
    const int row = tid >> 1, hf = tid & 1;
    const f32x4* p = (const f32x4*)(ssq + (size_t)(pm * 256 + row) * 16 + hf * 8);
    const f32x4 a = p[0], b = p[1];
    float s = ((a[0] + a[1]) + (a[2] + a[3])) + ((b[0] + b[1]) + (b[2] + b[3]));
    s += __shfl_xor(s, 1);
    if (hf == 0) dst[row] = 1.0f / sqrtf(s * (1.0f / 1024.0f) + EPS);
}
__device__ __forceinline__ void load_rstd(const LAS float* tbl, int wr, int fr, float (&rs)[2][4]) {
#pragma unroll
    for (int ai = 0; ai < 2; ++ai)
#pragma unroll
        for (int m = 0; m < 4; ++m) rs[ai][m] = tbl[ai * 128 + wr * 64 + m * 16 + fr];
}
__device__ __forceinline__ float silu_f(float x) { return x * __builtin_amdgcn_rcpf(1.0f + __builtin_amdgcn_exp2f(-x * LOG2E)); }

struct EpiU {
    static constexpr bool PERM = true, RSTD = true, INIT_BASE = false;
    bf16_t* U; const float* ssq;
    __device__ __forceinline__ void init_acc(AccT& acc, const pg8::Unit&, int, int, int, int) const { zero_acc(acc); }
    __device__ __forceinline__ void fill_rstd(LAS float* dst, int pm, int tid) const { fill_rstd_tbl(ssq, dst, pm, tid); }
    __device__ __forceinline__ void operator()(AccT& acc, const pg8::Unit& u, bool, const pg8::Unit&, const LAS float* tbl, int wr, int wc, int fr, int fq) const {
        const int row0 = u.pm * 256 + wr * 64 + fr;
        float rs[2][4]; load_rstd(tbl, wr, fr, rs);
        const int col0 = u.pn * 128 + wc * 32 + 8 * fq;
#pragma unroll
        for (int ai = 0; ai < 2; ++ai)
#pragma unroll
            for (int m = 0; m < 4; ++m) {
                const float r2 = rs[ai][m] * rs[ai][m];
                const f32x4 v0 = acc[ai][0][m][0] * acc[ai][1][m][0] * r2, v1 = acc[ai][0][m][1] * acc[ai][1][m][1] * r2;
                u32x4 w; w.x = cvt_pk_bf16(v0[0], v0[1]); w.y = cvt_pk_bf16(v0[2], v0[3]); w.z = cvt_pk_bf16(v1[0], v1[1]); w.w = cvt_pk_bf16(v1[2], v1[3]);
                *(u32x4*)(U + (size_t)(row0 + ai * 128 + m * 16) * D + col0) = w;
            }
        zero_acc(acc);
    }
};
struct EpiCz {
    static constexpr bool PERM = true, RSTD = true, INIT_BASE = false;
    const bf16_t* U; bf16_t* Z; const float* ssq; const LAS float* cw;
    __device__ __forceinline__ void init_acc(AccT& acc, const pg8::Unit&, int, int, int, int) const { zero_acc(acc); }
    __device__ __forceinline__ void fill_rstd(LAS float* dst, int pm, int tid) const { fill_rstd_tbl(ssq, dst, pm, tid); }
    __device__ __forceinline__ static unsigned ror_(unsigned p, int n) { return n == 1 ? (unsigned)__builtin_amdgcn_update_dpp(0, (int)p, 0x121, 0xf, 0xf, true) : (unsigned)__builtin_amdgcn_update_dpp(0, (int)p, 0x122, 0xf, 0xf, true); }
    __device__ __forceinline__ static unsigned above_(unsigned prev, unsigned cur, int n) {
        const unsigned old = ror_(prev, n);
        return n == 1 ? (unsigned)__builtin_amdgcn_update_dpp((int)old, (int)cur, 0x111, 0xf, 0xf, false) : (unsigned)__builtin_amdgcn_update_dpp((int)old, (int)cur, 0x112, 0xf, 0xf, false);
    }
    __device__ __forceinline__ void operator()(AccT& acc, const pg8::Unit& u, bool, const pg8::Unit&, const LAS float* tbl, int wr, int wc, int fr, int fq) const {
        const int row0 = u.pm * 256 + wr * 64 + fr;
        const int ch0 = u.pn * 256 + wc * 32 + 8 * fq;
        u32x4 uu[2][4][2], hh[2][2];
#define CZ_LOAD(ai) do { _Pragma("unroll") for (int bj = 0; bj < 2; ++bj) { hh[ai][bj] = (u32x4){0u, 0u, 0u, 0u}; const int hr = row0 + (ai) * 128 - 16; \
            if (fr >= 14 && hr >= 0) hh[ai][bj] = *(const u32x4*)(U + (size_t)hr * D + ch0 + bj * 128); } \
        _Pragma("unroll") for (int m = 0; m < 4; ++m) _Pragma("unroll") for (int bj = 0; bj < 2; ++bj) uu[ai][m][bj] = *(const u32x4*)(U + (size_t)(row0 + (ai) * 128 + m * 16) * D + ch0 + bj * 128); } while (0)
#define CZ_GROUP(ai, m) do { const int row = row0 + (ai) * 128 + (m) * 16; const float r = rs[ai][m]; \
        _Pragma("unroll") for (int bj = 0; bj < 2; ++bj) { const LAS float* wp = cw + ch0 + bj * 128; \
            const u32x4 u0 = uu[ai][m][bj], pv = ((m) == 0) ? hh[ai][bj] : uu[ai][(m) == 0 ? 0 : (m) - 1][bj]; u32x4 u1, u2; \
            _Pragma("unroll") for (int k = 0; k < 4; ++k) { u1[k] = above_(pv[k], u0[k], 1); u2[k] = above_(pv[k], u0[k], 2); } \
            if ((ai) == 0 && (m) == 0) { const int t = row & (SEQ - 1); if (t < 1) u1 = (u32x4){0u, 0u, 0u, 0u}; if (t < 2) u2 = (u32x4){0u, 0u, 0u, 0u}; } \
            f32x4 z[2]; \
            _Pragma("unroll") for (int n = 0; n < 2; ++n) { \
                const f32x4 w0 = *(const LAS f32x4*)(wp + 4 * n), w1 = *(const LAS f32x4*)(wp + D + 4 * n), w2 = *(const LAS f32x4*)(wp + 2 * D + 4 * n); \
                const f32x4 a0 = (f32x4){bf_lo(u0[2 * n]), bf_hi(u0[2 * n]), bf_lo(u0[2 * n + 1]), bf_hi(u0[2 * n + 1])}; \
                const f32x4 a1 = (f32x4){bf_lo(u1[2 * n]), bf_hi(u1[2 * n]), bf_lo(u1[2 * n + 1]), bf_hi(u1[2 * n + 1])}; \
                const f32x4 a2 = (f32x4){bf_lo(u2[2 * n]), bf_hi(u2[2 * n]), bf_lo(u2[2 * n + 1]), bf_hi(u2[2 * n + 1])}; \
                z[n] = (acc[ai][bj][m][n] * r) * (w0 * a2 + w1 * a1 + w2 * a0); } \
            u32x4 w; w.x = cvt_pk_bf16(z[0][0], z[0][1]); w.y = cvt_pk_bf16(z[0][2], z[0][3]); w.z = cvt_pk_bf16(z[1][0], z[1][1]); w.w = cvt_pk_bf16(z[1][2], z[1][3]); \
            *(u32x4*)(Z + (size_t)row * D + ch0 + bj * 128) = w; } } while (0)
        CZ_LOAD(0);
        float rs[2][4]; load_rstd(tbl, wr, fr, rs);
        __builtin_amdgcn_sched_barrier(0);
        CZ_GROUP(0, 0); CZ_GROUP(0, 1); CZ_GROUP(0, 2);
        __builtin_amdgcn_sched_barrier(0);
        CZ_LOAD(1);
        __builtin_amdgcn_sched_barrier(0);
        CZ_GROUP(0, 3);
        CZ_GROUP(1, 0); CZ_GROUP(1, 1); CZ_GROUP(1, 2); CZ_GROUP(1, 3);
#undef CZ_LOAD
#undef CZ_GROUP
        zero_acc(acc);
    }
};
struct EpiGu {
    static constexpr bool PERM = true, RSTD = true, INIT_BASE = false;
    bf16_t* ACT; const float* ssq;
    __device__ __forceinline__ void init_acc(AccT& acc, const pg8::Unit&, int, int, int, int) const { zero_acc(acc); }
    __device__ __forceinline__ void fill_rstd(LAS float* dst, int pm, int tid) const { fill_rstd_tbl(ssq, dst, pm, tid); }
    __device__ __forceinline__ void operator()(AccT& acc, const pg8::Unit& u, bool, const pg8::Unit&, const LAS float* tbl, int wr, int wc, int fr, int fq) const {
        const int row0 = u.pm * 256 + wr * 64 + fr;
        float rs[2][4]; load_rstd(tbl, wr, fr, rs);
        const int col0 = u.pn * 128 + wc * 32 + 8 * fq;
#pragma unroll
        for (int ai = 0; ai < 2; ++ai)
#pragma unroll
            for (int m = 0; m < 4; ++m) {
                const float r = rs[ai][m], r2 = r * r, nrl = -r * LOG2E;
                f32x4 v[2];
#pragma unroll
                for (int n = 0; n < 2; ++n) {
                    const f32x4 gg = acc[ai][0][m][n], p = (gg * acc[ai][1][m][n]) * r2, t = gg * nrl;
                    f32x4 d;
#pragma unroll
                    for (int i = 0; i < 4; ++i) d[i] = __builtin_amdgcn_exp2f(t[i]);
                    d = d + 1.0f;
#pragma unroll
                    for (int i = 0; i < 4; ++i) d[i] = __builtin_amdgcn_rcpf(d[i]);
                    v[n] = p * d;
                }
                u32x4 w; w.x = cvt_pk_bf16(v[0][0], v[0][1]); w.y = cvt_pk_bf16(v[0][2], v[0][3]); w.z = cvt_pk_bf16(v[1][0], v[1][1]); w.w = cvt_pk_bf16(v[1][2], v[1][3]);
                __builtin_nontemporal_store(w, (u32x4*)(ACT + (size_t)(row0 + ai * 128 + m * 16) * DFF + col0));
            }
        zero_acc(acc);
    }
};
template <int MODE> struct EpiRes {
    static constexpr bool PERM = true, RSTD = false, INIT_BASE = true;
    const float* basef; bf16_t* xb; float* outf; float* ssq;
    __device__ __forceinline__ void fill_rstd(LAS float*, int, int) const {}
    __device__ __forceinline__ static void expand(AccT& acc, int ai, int bj, int m, const u32x4 w) {
        acc[ai][bj][m][0] = (f32x4){bf_lo(w.x), bf_hi(w.x), bf_lo(w.y), bf_hi(w.y)}; acc[ai][bj][m][1] = (f32x4){bf_lo(w.z), bf_hi(w.z), bf_lo(w.w), bf_hi(w.w)};
    }
    __device__ __forceinline__ void load_group_f32(AccT& acc, int ai, int m, size_t off) const {
#pragma unroll
        for (int bj = 0; bj < 2; ++bj)
#pragma unroll
            for (int n = 0; n < 2; ++n) acc[ai][bj][m][n] = *(const f32x4*)(basef + off + bj * 128 + 4 * n);
    }
    __device__ __forceinline__ void init_acc(AccT& acc, const pg8::Unit& u, int wr, int wc, int fr, int fq) const {
        const int row0 = u.pm * 256 + wr * 64 + fr, col0 = u.pn * 256 + wc * 32 + 8 * fq;
#pragma unroll
        for (int ai = 0; ai < 2; ++ai)
#pragma unroll
            for (int m = 0; m < 4; ++m) {
                const size_t off = (size_t)(row0 + ai * 128 + m * 16) * D + col0;
                if (MODE == 0) load_group_f32(acc, ai, m, off);
                else {
#pragma unroll
                    for (int bj = 0; bj < 2; ++bj) expand(acc, ai, bj, m, *(const u32x4*)(xb + off + bj * 128));
                }
            }
    }
    __device__ __forceinline__ void finish_init(AccT& acc) const {
        __builtin_amdgcn_sched_barrier(0);
#pragma unroll
        for (int a = 0; a < 2; ++a)
#pragma unroll
            for (int b = 0; b < 2; ++b)
#pragma unroll
                for (int m = 0; m < 4; ++m)
#pragma unroll
                    for (int n = 0; n < 2; ++n) asm volatile("" : "+v"(acc[a][b][m][n]));
    }
    __device__ __forceinline__ void operator()(AccT& acc, const pg8::Unit& u, bool has_next, const pg8::Unit& nx, const LAS float*, int wr, int wc, int fr, int fq) const {
        const int row0 = u.pm * 256 + wr * 64 + fr, col0 = u.pn * 256 + wc * 32 + 8 * fq;
        const int nrow0 = nx.pm * 256 + wr * 64 + fr, ncol0 = nx.pn * 256 + wc * 32 + 8 * fq;
        u32x4 t[2][4][2];
        if (MODE != 0 && has_next) {
#pragma unroll
            for (int ai = 0; ai < 2; ++ai)
#pragma unroll
                for (int m = 0; m < 4; ++m) {
                    const size_t noff = (size_t)(nrow0 + ai * 128 + m * 16) * D + ncol0;
#pragma unroll
                    for (int bj = 0; bj < 2; ++bj) t[ai][m][bj] = *(const u32x4*)(xb + noff + bj * 128);
                }
            __builtin_amdgcn_sched_barrier(0);
        }
#pragma unroll
        for (int ai = 0; ai < 2; ++ai)
#pragma unroll
            for (int m = 0; m < 4; ++m) {
                const size_t off = (size_t)(row0 + ai * 128 + m * 16) * D + col0; float s = 0.f;
#pragma unroll
                for (int bj = 0; bj < 2; ++bj) {
                    const f32x4 o0 = acc[ai][bj][m][0], o1 = acc[ai][bj][m][1];
                    if (MODE == 2) { __builtin_nontemporal_store(o0, (f32x4*)(outf + off + bj * 128)); __builtin_nontemporal_store(o1, (f32x4*)(outf + off + bj * 128 + 4)); }
                    else {
                        s += ((o0[0] * o0[0] + o0[1] * o0[1]) + (o0[2] * o0[2] + o0[3] * o0[3])) + ((o1[0] * o1[0] + o1[1] * o1[1]) + (o1[2] * o1[2] + o1[3] * o1[3]));
                        u32x4 w; w.x = cvt_pk_bf16(o0[0], o0[1]); w.y = cvt_pk_bf16(o0[2], o0[3]); w.z = cvt_pk_bf16(o1[0], o1[1]); w.w = cvt_pk_bf16(o1[2], o1[3]);
                        *(u32x4*)(xb + off + bj * 128) = w;
                    }
                }
                if (MODE != 2) {
                    s += __shfl_xor(s, 16); s += __shfl_xor(s, 32);
                    if (fq == 0) ssq[(size_t)(row0 + ai * 128 + m * 16) * 16 + u.pn * 4 + wc] = s;
                }
                if (MODE == 0) { if (has_next) load_group_f32(acc, ai, m, (size_t)(nrow0 + ai * 128 + m * 16) * D + ncol0); }
            }
        if (MODE != 0 && has_next) {
            __builtin_amdgcn_sched_barrier(0);
#pragma unroll
            for (int ai = 0; ai < 2; ++ai)
#pragma unroll
                for (int m = 0; m < 4; ++m)
#pragma unroll
                    for (int bj = 0; bj < 2; ++bj) expand(acc, ai, bj, m, t[ai][m][bj]);
        }
    }
};
struct EpiQkv {
    static constexpr bool PERM = true, RSTD = true, INIT_BASE = false;
    bf16_t* Q; bf16_t* Kb; bf16_t* Vt; const float* ssq; const float* qg; const float* kg;
    __device__ __forceinline__ void init_acc(AccT& acc, const pg8::Unit&, int, int, int, int) const { zero_acc(acc); }
    __device__ __forceinline__ void fill_rstd(LAS float* dst, int pm, int tid) const { fill_rstd_tbl(ssq, dst, pm, tid); }
    __device__ __forceinline__ void operator()(AccT& acc, const pg8::Unit& u, bool, const pg8::Unit&, const LAS float* tbl, int wr, int wc, int fr, int fq) const {
        const int row0 = u.pm * 256 + wr * 64 + fr;
        float rs[2][4]; load_rstd(tbl, wr, fr, rs);
        if (u.pn < 5) {
            const bool isq = u.pn < 4;
            const float* gain = isq ? qg : kg; const float sc = isq ? 0.125f * LOG2E : 1.0f;
            bf16_t* dst = isq ? Q + (4 * u.pn + wc) * 64 : Kb + wc * 64; const int ld = isq ? 1024 : 256;
            f32x4 gv[2][2];
#pragma unroll
            for (int bj = 0; bj < 2; ++bj)
#pragma unroll
                for (int n = 0; n < 2; ++n) gv[bj][n] = *(const f32x4*)(gain + 32 * bj + 8 * fq + 4 * n) * sc;
#pragma unroll
            for (int ai = 0; ai < 2; ++ai)
#pragma unroll
                for (int m = 0; m < 4; ++m) {
                    const float r = rs[ai][m]; float ss = 0.f; f32x4 v[2][2];
#pragma unroll
                    for (int bj = 0; bj < 2; ++bj)
#pragma unroll
                        for (int n = 0; n < 2; ++n) { v[bj][n] = acc[ai][bj][m][n] * r; const f32x4 t = v[bj][n]; ss += (t[0] * t[0] + t[1] * t[1]) + (t[2] * t[2] + t[3] * t[3]); }
                    ss += __shfl_xor(ss, 16); ss += __shfl_xor(ss, 32);
                    const float rq = 1.0f / sqrtf(ss * (1.0f / 64.0f) + EPS);
                    bf16_t* rowp = dst + (size_t)(row0 + ai * 128 + m * 16) * ld + 8 * fq;
#pragma unroll
                    for (int bj = 0; bj < 2; ++bj) { const f32x4 o0 = v[bj][0] * rq * gv[bj][0], o1 = v[bj][1] * rq * gv[bj][1];
                        u32x4 w; w.x = cvt_pk_bf16(o0[0], o0[1]); w.y = cvt_pk_bf16(o0[2], o0[3]); w.z = cvt_pk_bf16(o1[0], o1[1]); w.w = cvt_pk_bf16(o1[2], o1[3]); *(u32x4*)(rowp + 32 * bj) = w; }
                }
        } else {
#pragma unroll
            for (int ai = 0; ai < 2; ++ai)
#pragma unroll
                for (int m = 0; m < 4; ++m) {
                    const int row = row0 + ai * 128 + m * 16; const float r = rs[ai][m];
                    bf16_t* p = Vt + ((size_t)((row >> 11) * 4 + wc) * 64 + 8 * fq) * SEQ + (row & (SEQ - 1));
                    const int par = fr & 1;
#pragma unroll
                    for (int bj = 0; bj < 2; ++bj)
#pragma unroll
                        for (int n = 0; n < 2; ++n) { const f32x4 o = acc[ai][bj][m][n] * r;
#pragma unroll
                            for (int i = 0; i < 4; i += 2) {
                                const unsigned w = cvt_pk_bf16(o[i], o[i + 1]);
                                const unsigned wp = (unsigned)__builtin_amdgcn_update_dpp(0, (int)w, 0xB1, 0xf, 0xf, true);
                                const unsigned word = par ? ((wp >> 16) | (w & 0xffff0000u)) : ((w & 0xffffu) | (wp << 16));
                                *(unsigned*)(p - par + (size_t)(32 * bj + 4 * n + i + par) * SEQ) = word; } }
                }
        }
        zero_acc(acc);
    }
};

constexpr size_t MiB = 1u << 20;
constexpr size_t WS_WIN = 1 * MiB, WS_WOUT = 7 * MiB, WS_GU0 = 9 * MiB, WS_DN0 = 20 * MiB, WS_WQKV = 26 * MiB, WS_WO = 29 * MiB, WS_GU1 = 31 * MiB, WS_DN1 = 42 * MiB;
constexpr size_t WS_SSQ = 48 * MiB;
constexpr size_t WS_XB = 64 * MiB;
constexpr size_t WS_R = 192 * MiB;
constexpr size_t WS_U = WS_R, WS_C = WS_R + 128 * MiB, WS_Z = WS_R + 256 * MiB;
constexpr size_t WS_ACT = WS_R;
constexpr size_t WS_Q = WS_R, WS_K = WS_R + 128 * MiB, WS_VT = WS_R + 160 * MiB, WS_ATT = WS_R + 192 * MiB;
constexpr size_t WS_END = WS_R + 384 * MiB;

constexpr int CW_OFF = 131072 + 2048;
constexpr int MISC_OFF = 147456 - 256;
constexpr int LDS_BYTES = 147456;
constexpr int NWAVES = 8;

__device__ __forceinline__ int map_row(int kind, int n0) {
    if (kind == 1) { if (n0 < 1024) return 256 * (n0 >> 7) + (n0 & 127); if (n0 < 2048) return 2048 + (n0 - 1024); const int n = n0 - 2048; return 256 * (n >> 7) + 128 + (n & 127); }
    if (kind == 2) { if (n0 < DFF) return 256 * (n0 >> 7) + (n0 & 127); const int n = n0 - DFF; return 256 * (n >> 7) + 128 + (n & 127); }
    if (kind == 3) { if (n0 < 1024) { const int hd = n0 >> 6, d0 = n0 & 63; return 256 * (hd >> 2) + 128 * (d0 >> 5) + 32 * (hd & 3); }
        const int n = n0 - 1024, t = n >> 8, n2 = n & 255, wc = n2 >> 6, d0 = n2 & 63; return 1024 + 256 * t + 128 * (d0 >> 5) + 32 * wc; }
    return n0;
}
__device__ __forceinline__ void p0_item(const float* W, int K, int N, bf16_t* WT, const float* gain, int kind, LAS float* scr, int item, int lane) {
    const int nblk = N / 32, kb = item / nblk, nb = item % nblk, k0 = 64 * kb, n0 = 32 * nb;
#pragma unroll 8
    for (int i = 0; i < 32; ++i) { const int kk = 2 * i + (lane >> 5); const float gsc = gain ? gain[k0 + kk] : 1.0f; scr[kk * 33 + (lane & 31)] = W[(size_t)(k0 + kk) * N + n0 + (lane & 31)] * gsc; }
    asm volatile("s_waitcnt lgkmcnt(0)" ::: "memory");
    const int c = lane & 7; const int r0 = map_row(kind, n0);
#pragma unroll
    for (int j = 0; j < 4; ++j) { const int n = (lane >> 3) + 8 * j; const LAS float* s = scr + (8 * c) * 33 + n;
        u32x4 o; o.x = cvt_pk_bf16(s[0 * 33], s[1 * 33]); o.y = cvt_pk_bf16(s[2 * 33], s[3 * 33]); o.z = cvt_pk_bf16(s[4 * 33], s[5 * 33]); o.w = cvt_pk_bf16(s[6 * 33], s[7 * 33]);
        *(u32x4*)(WT + (size_t)(r0 + n) * K + k0 + 8 * c) = o; }
    asm volatile("s_waitcnt lgkmcnt(0)" ::: "memory");
}
__device__ __forceinline__ float wave_sum(float v) {
#pragma unroll
    for (int o = 1; o < 64; o <<= 1) v += __shfl_xor(v, o);
    return v;
}

struct Args {
    const float* x; const float* conv_w_in; const float* conv_w; const float* conv_w_out; const float* w_qkv; const float* q_gain; const float* k_gain; const float* sinks;
    const float* w_o; const float* norm_mixer; const float* norm_ffn; const float* w_gu; const float* w_dn;
    float* out; unsigned char* ws; int ph_lo, ph_hi;
};

__device__ __forceinline__ void p0_prologue(const Args& a, LAS unsigned char* lds, int gw, int NGW, int lane, int wave) {
    LAS float* scr = (LAS float*)(lds + wave * 16384);
    unsigned char* ws = a.ws;
    constexpr int I_WIN = 16 * 96, I_SQ = 16 * 32, I_GU = 16 * 176, I_DN = 44 * 32, I_QKV = 16 * 48;
    constexpr int NITEMS = I_WIN + I_SQ + I_GU + I_DN + I_QKV + I_SQ + I_GU + I_DN;
    for (int it = gw; it < NITEMS; it += NGW) {
        int r = it;
        if (r < I_WIN) { p0_item(a.conv_w_in, D, 3 * D, (bf16_t*)(ws + WS_WIN), a.norm_mixer, 1, scr, r, lane); continue; } r -= I_WIN;
        if (r < I_SQ) { p0_item(a.conv_w_out, D, D, (bf16_t*)(ws + WS_WOUT), nullptr, 0, scr, r, lane); continue; } r -= I_SQ;
        if (r < I_GU) { p0_item(a.w_gu, D, 2 * DFF, (bf16_t*)(ws + WS_GU0), a.norm_ffn, 2, scr, r, lane); continue; } r -= I_GU;
        if (r < I_DN) { p0_item(a.w_dn, DFF, D, (bf16_t*)(ws + WS_DN0), nullptr, 0, scr, r, lane); continue; } r -= I_DN;
        if (r < I_QKV) { p0_item(a.w_qkv, D, NQKV, (bf16_t*)(ws + WS_WQKV), a.norm_mixer + D, 3, scr, r, lane); continue; } r -= I_QKV;
        if (r < I_SQ) { p0_item(a.w_o, D, D, (bf16_t*)(ws + WS_WO), nullptr, 0, scr, r, lane); continue; } r -= I_SQ;
        if (r < I_GU) { p0_item(a.w_gu + (size_t)D * 2 * DFF, D, 2 * DFF, (bf16_t*)(ws + WS_GU1), a.norm_ffn + D, 2, scr, r, lane); continue; } r -= I_GU;
        p0_item(a.w_dn + (size_t)DFF * D, DFF, D, (bf16_t*)(ws + WS_DN1), nullptr, 0, scr, r, lane);
    }
    bf16_t* xb = (bf16_t*)(ws + WS_XB); float* ssq = (float*)(ws + WS_SSQ);
    for (int m0 = gw; m0 < M; m0 += 2 * NGW) {
        const int m1 = m0 + NGW; const bool two = m1 < M;
        f32x4 v[2][4];
#pragma unroll
        for (int q = 0; q < 2; ++q) { const int m = q ? (two ? m1 : m0) : m0; const f32x4* xr = (const f32x4*)(a.x + (size_t)m * D) + 2 * lane;
#pragma unroll
            for (int j = 0; j < 2; ++j) { v[q][2 * j] = xr[128 * j]; v[q][2 * j + 1] = xr[128 * j + 1]; } }
#pragma unroll
        for (int q = 0; q < 2; ++q) {
            if (q == 1 && !two) break;
            const int m = q ? m1 : m0; float s = 0.f;
#pragma unroll
            for (int j = 0; j < 4; ++j) s += (v[q][j][0] * v[q][j][0] + v[q][j][1] * v[q][j][1]) + (v[q][j][2] * v[q][j][2] + v[q][j][3] * v[q][j][3]);
            s = wave_sum(s);
            u32x4* o16 = (u32x4*)(xb + (size_t)m * D) + lane;
#pragma unroll
            for (int j = 0; j < 2; ++j) { u32x4 w; w.x = cvt_pk_bf16(v[q][2 * j][0], v[q][2 * j][1]); w.y = cvt_pk_bf16(v[q][2 * j][2], v[q][2 * j][3]); w.z = cvt_pk_bf16(v[q][2 * j + 1][0], v[q][2 * j + 1][1]); w.w = cvt_pk_bf16(v[q][2 * j + 1][2], v[q][2 * j + 1][3]); o16[64 * j] = w; }
            if (lane < 16) ssq[(size_t)m * 16 + lane] = (lane == 0) ? s : 0.f;
        }
    }
}

constexpr int AT_KS = 0, AT_KSTR = 144, AT_VS = 256 * AT_KSTR, AT_VSTR = 520, AT_L = AT_VS + 64 * AT_VSTR, AT_STG = AT_L + 1024;
__device__ __forceinline__ void attn_phase(const Args& a, LAS unsigned char* lds, int cu, int G, int wid) {
    const bf16_t* Q = (const bf16_t*)(a.ws + WS_Q); const bf16_t* Kb = (const bf16_t*)(a.ws + WS_K); const bf16_t* Vt = (const bf16_t*)(a.ws + WS_VT); bf16_t* O = (bf16_t*)(a.ws + WS_ATT);
    const int lane = lane_id(), tid = wid * 64 + lane, r = lane & 31, h = lane >> 5;
    LAS float* lw = (LAS float*)(lds + AT_L) + wid * 32;
    bf16x8 qn[4];
    if (cu < 32 * 16 * 4) { const int kvh_ = cu & 3, nb_ = (cu >> 2) & 15, b_ = cu >> 6; const size_t qt_ = (size_t)b_ * SEQ + nb_ * 128 + 32 * (2 * (wid & 1));
#pragma unroll
      for (int s = 0; s < 4; ++s) qn[s] = *(const bf16x8*)(Q + (qt_ + r) * D + (4 * kvh_ + (wid >> 1)) * 64 + 16 * s + 8 * h); }
    for (int ui = cu; ui < 32 * 16 * 4; ui += G) {
        const int kvh = ui & 3, nb = (ui >> 2) & 15, b = ui >> 6;
        const int tok0 = b * SEQ + (nb - 1) * 128;
#pragma unroll
        for (int i = 0; i < 4; ++i) {
            const int c = tid + 512 * i, row = c >> 3, chk = c & 7;
            u32x4 v = (u32x4){0u, 0u, 0u, 0u};
            if (nb > 0 || row >= 128) v = *(const u32x4*)(Kb + (size_t)(tok0 + row) * 256 + kvh * 64 + chk * 8);
            *(LAS u32x4*)(lds + AT_KS + row * AT_KSTR + chk * 16) = v;
        }
#pragma unroll
        for (int i = 0; i < 4; ++i) {
            const int c = tid + 512 * i, d = c >> 5, chk = c & 31;
            u32x4 v = (u32x4){0u, 0u, 0u, 0u};
            if (nb > 0 || chk >= 16) v = *(const u32x4*)(Vt + ((size_t)(b * 4 + kvh) * 64 + d) * SEQ + (nb - 1) * 128 + chk * 8);
            LAS u32x2* p = (LAS u32x2*)(lds + AT_VS + d * AT_VSTR + chk * 16);
            p[0] = (u32x2){v.x, v.y}; p[1] = (u32x2){v.z, v.w};
        }
        __syncthreads();
        const int g = wid >> 1, hq = 4 * kvh + g;
        const float slope2 = exp2f(-0.5f * (float)(hq + 1)) * LOG2E, sink2 = a.sinks[hq] * LOG2E;
        for (int sbi = 0; sbi < 2; ++sbi) {
            const int sb = 2 * (wid & 1) + sbi;
            const size_t qtok = (size_t)b * SEQ + nb * 128 + 32 * sb;
            bf16x8 qf[4];
#pragma unroll
            for (int s = 0; s < 4; ++s) qf[s] = qn[s];
            {
                const int nu = (sbi == 0) ? ui : ui + G;
                if (nu < 32 * 16 * 4) { const int kvh_ = nu & 3, nb_ = (nu >> 2) & 15, b_ = nu >> 6; const size_t qt_ = (size_t)b_ * SEQ + nb_ * 128 + 32 * (2 * (wid & 1) + (sbi ^ 1));
#pragma unroll
                    for (int s = 0; s < 4; ++s) qn[s] = *(const bf16x8*)(Q + (qt_ + r) * D + (4 * kvh_ + (wid >> 1)) * 64 + 16 * s + 8 * h); }
            }
            f32x16 st[5];
#pragma unroll
            for (int kt = 0; kt < 5; ++kt) {
                const int kb = 32 * (sb + kt);
                st[kt] = (f32x16){0.f, 0.f, 0.f, 0.f, 0.f, 0.f, 0.f, 0.f, 0.f, 0.f, 0.f, 0.f, 0.f, 0.f, 0.f, 0.f};
#pragma unroll
                for (int s = 0; s < 4; ++s) {
                    const bf16x8 kf = *(const LAS bf16x8*)(lds + AT_KS + (kb + r) * AT_KSTR + (16 * s + 8 * h) * 2);
                    st[kt] = __builtin_amdgcn_mfma_f32_32x32x16_bf16(kf, qf[s], st[kt], 0, 0, 0);
                }
                __builtin_amdgcn_sched_barrier(0);
            }
            int rr = r, hh = h; asm volatile("" : "+v"(rr), "+v"(hh));
            const int basei = rr + 128 - 4 * hh; const float nsb = -slope2 * (float)basei;
            float mx = sink2;
#pragma unroll
            for (int kt = 0; kt < 5; ++kt) {
                const bool tv = (nb > 0) || (sb + kt >= 4);
#pragma unroll
                for (int i = 0; i < 16; ++i) {
                    const int c = 32 * kt + (i & 3) + 8 * (i >> 2);
                    float v = (st[kt][i] + slope2 * (float)c) + nsb;
                    bool valid = tv;
                    if (kt == 0) valid = valid && (basei - c < 128);
                    if (kt == 4) valid = valid && (basei - c >= 0);
                    v = valid ? v : -INFINITY;
                    st[kt][i] = v; mx = fmaxf(mx, v);
                }
            }
            mx = fmaxf(mx, __shfl_xor(mx, 32));
            float l = 0.f;
#pragma unroll
            for (int kt = 0; kt < 5; ++kt)
#pragma unroll
                for (int i = 0; i < 16; ++i) { const float p = __builtin_amdgcn_exp2f(st[kt][i] - mx); st[kt][i] = p; l += p; }
            l += __shfl_xor(l, 32);
            l += __builtin_amdgcn_exp2f(sink2 - mx);
            if (h == 0) lw[r] = l;
            f32x16 o[2];
            o[0] = (f32x16){0.f, 0.f, 0.f, 0.f, 0.f, 0.f, 0.f, 0.f, 0.f, 0.f, 0.f, 0.f, 0.f, 0.f, 0.f, 0.f}; o[1] = o[0];
#pragma unroll
            for (int kt = 0; kt < 5; ++kt)
#pragma unroll
                for (int s2 = 0; s2 < 2; ++s2) {
                    u32x4 pw; pw.x = cvt_pk_bf16(st[kt][8 * s2 + 0], st[kt][8 * s2 + 1]); pw.y = cvt_pk_bf16(st[kt][8 * s2 + 2], st[kt][8 * s2 + 3]);
                    pw.z = cvt_pk_bf16(st[kt][8 * s2 + 4], st[kt][8 * s2 + 5]); pw.w = cvt_pk_bf16(st[kt][8 * s2 + 6], st[kt][8 * s2 + 7]);
                    const bf16x8 pa = __builtin_bit_cast(bf16x8, pw);
                    const int kb = 32 * (sb + kt) + 16 * s2 + 4 * h;
#pragma unroll
                    for (int c = 0; c < 2; ++c) {
                        const LAS unsigned char* vp = lds + AT_VS + (32 * c + r) * AT_VSTR + kb * 2;
                        const u32x2 lo = *(const LAS u32x2*)vp, hi = *(const LAS u32x2*)(vp + 16);
                        const u32x4 vw = (u32x4){lo.x, lo.y, hi.x, hi.y};
                        o[c] = __builtin_amdgcn_mfma_f32_32x32x16_bf16(pa, __builtin_bit_cast(bf16x8, vw), o[c], 0, 0, 0);
                    }
                    __builtin_amdgcn_sched_barrier(0);
                }
            asm volatile("s_waitcnt lgkmcnt(0)" ::: "memory");
            LAS bf16_t* stg = (LAS bf16_t*)(lds + AT_STG) + wid * 2048;
#pragma unroll
            for (int i = 0; i < 16; ++i) {
                const int qr = (i & 3) + 8 * (i >> 2) + 4 * h;
                const float li = __builtin_amdgcn_rcpf(lw[qr]);
                const unsigned w = cvt_pk_bf16(o[0][i] * li, o[1][i] * li);
                stg[qr * 64 + r] = (bf16_t)(w & 0xffffu); stg[qr * 64 + 32 + r] = (bf16_t)(w >> 16);
            }
            asm volatile("s_waitcnt lgkmcnt(0)" ::: "memory");
#pragma unroll
            for (int j = 0; j < 4; ++j) {
                const int row = j * 8 + (lane >> 3), ch = lane & 7;
                const u32x4 v = *(const LAS u32x4*)(stg + row * 64 + ch * 8);
                *(u32x4*)(O + (qtok + row) * D + hq * 64 + ch * 8) = v;
            }
            asm volatile("s_waitcnt lgkmcnt(0)" ::: "memory");
        }
        __syncthreads();
    }
}

#define XB_TMO      128
#define XB_XCNT(j)  (256  + 64 * (j))
#define XB_XSUB(j)  (1280 + 64 * (j))
#define XB_XGEN(j)  (2304 + 64 * (j))
#define XB_TOP      3328
#define XB_TOPGEN   3392
#define XCD_BAR_WORDS 3456
#define XB_SPIN_CAP (1u << 18)

__device__ __forceinline__ unsigned xb_ld(unsigned* p)              { return __hip_atomic_load(p, __ATOMIC_RELAXED, __HIP_MEMORY_SCOPE_AGENT); }
__device__ __forceinline__ unsigned xb_add(unsigned* p, unsigned v) { return __hip_atomic_fetch_add(p, v, __ATOMIC_RELAXED, __HIP_MEMORY_SCOPE_AGENT); }
__device__ __forceinline__ unsigned xb_xcc_id() { return (unsigned)__builtin_amdgcn_s_getreg((3 << 11) | 20) & 0xFu; }
#define XB_SPIN(cond, bar) do { unsigned _sp = 0; while (cond) { __builtin_amdgcn_s_sleep(1); \
    if ((++_sp & 255u) == 0u) { if (xb_ld(&(bar)[XB_TMO])) break; if (_sp > XB_SPIN_CAP) { atomicAdd(&(bar)[XB_TMO], 1u); break; } } } } while (0)

struct XcdBarrier {
    unsigned* bar; unsigned x; unsigned w;
    volatile LAS unsigned* st;
};

__device__ __forceinline__ XcdBarrier xcd_barrier_post(unsigned* bar, volatile LAS unsigned* st) {
    XcdBarrier b; b.bar = bar; b.x = xb_xcc_id(); b.st = st; b.w = 0u;
    if (threadIdx.x == 0) (void)xb_add(&bar[XB_XCNT(b.x)], 1u);
    return b;
}
__device__ __forceinline__ void xcd_barrier_complete(unsigned* bar, unsigned x, unsigned& nloc, unsigned& nx) {
    const unsigned G = gridDim.x * gridDim.y * gridDim.z;
    unsigned sum, cnt, mine, sp = 0u;
    for (;;) {
        sum = 0u; cnt = 0u; mine = 0u;
#pragma unroll
        for (unsigned j = 0; j < 16; ++j) { const unsigned c = xb_ld(&bar[XB_XCNT(j)]); sum += c; cnt += (c > 0u) ? 1u : 0u; mine = (j == x) ? c : mine; }
        if (sum == G) break;
        __builtin_amdgcn_s_sleep(1);
        if ((++sp & 255u) == 0u) { if (xb_ld(&bar[XB_TMO])) break; if (sp > XB_SPIN_CAP) { atomicAdd(&bar[XB_TMO], 1u); break; } }
    }
    nloc = mine > 0u ? mine : 1u; nx = cnt > 0u ? cnt : 1u;
}

__device__ __forceinline__ void xcd_barrier(const XcdBarrier& b) {
    asm volatile("s_waitcnt vmcnt(0)" ::: "memory");
    __syncthreads();
    if (b.w == 0u && lane_id() == 0) {
        unsigned* bar = b.bar;
        __builtin_amdgcn_s_waitcnt(0);
        unsigned nloc = b.st[0], nx = b.st[1];
        if (nloc == 0u) { xcd_barrier_complete(bar, b.x, nloc, nx); b.st[0] = nloc; b.st[1] = nx; }
        const unsigned old = xb_add(&bar[XB_XSUB(b.x)], 1u);
        const unsigned gen = old / nloc;
        if (old + 1u == (gen + 1u) * nloc) {
            __builtin_amdgcn_fence(__ATOMIC_RELEASE, "agent");
            asm volatile("s_waitcnt vmcnt(0)" ::: "memory");
            const unsigned og = xb_add(&bar[XB_TOP], 1u);
            const unsigned tg = og / nx;
            if (og + 1u == (tg + 1u) * nx) xb_add(&bar[XB_TOPGEN], 1u);
            else XB_SPIN(xb_ld(&bar[XB_TOPGEN]) == tg, bar);
            __builtin_amdgcn_fence(__ATOMIC_ACQUIRE, "agent");
            xb_add(&bar[XB_XGEN(b.x)], 1u);
            asm volatile("s_waitcnt vmcnt(0)" ::: "memory");
        } else {
            XB_SPIN(xb_ld(&bar[XB_XGEN(b.x)]) == gen, bar);
            __builtin_amdgcn_fence(__ATOMIC_ACQUIRE, "agent");
            asm volatile("s_waitcnt vmcnt(0)" ::: "memory");
        }
    }
    __syncthreads();
}


__global__ void __launch_bounds__(NWAVES * 64, 2) fwd_kernel(Args a) {
    extern __shared__ __attribute__((aligned(16))) unsigned char lds_raw[];
    LAS unsigned char* lds = (LAS unsigned char*)lds_raw;
    const int wave = __builtin_amdgcn_readfirstlane(threadIdx.x >> 6);
    const int G = gridDim.x, bx = blockIdx.x;
    unsigned char* ws = a.ws;
    float* ssq = (float*)(ws + WS_SSQ); bf16_t* xb = (bf16_t*)(ws + WS_XB);
    volatile LAS unsigned* misc = (volatile LAS unsigned*)(lds + MISC_OFF);
    if (threadIdx.x < 16) misc[threadIdx.x] = 0u;
    __syncthreads();
    XcdBarrier xbar = xcd_barrier_post((unsigned*)ws, misc); xbar.w = (unsigned)wave;
#define SEAM() xcd_barrier(xbar)
    if (a.ph_hi > 1000) cg::this_grid().sync();
    { const int vcu = (G % 8 == 0) ? (bx % 8) * (G / 8) + bx / 8 : bx; p0_prologue(a, lds, vcu * NWAVES + wave, G * NWAVES, lane_id(), wave); }
    SEAM();
    {
        pg8::Gemm g{xb, (const bf16_t*)(ws + WS_WIN), M, 2 * D, D}; pg8::StaticOrder S; S.init(M, 2 * D, G, bx);
        EpiU E{(bf16_t*)(ws + WS_U), ssq};
        pg8::gemm_phase<EpiU>(lds, g, S, E, wave);
    }
    SEAM();
    {
        LAS float* cw = (LAS float*)(lds + CW_OFF);
        for (int i = wave * 64 + lane_id(); i < 3 * D; i += NWAVES * 64) cw[i] = a.conv_w[i];
        __syncthreads();
        pg8::Gemm g{xb, (const bf16_t*)(ws + WS_WIN) + (size_t)2 * D * D, M, D, D}; pg8::StaticOrder S; S.init(M, D, G, bx);
        EpiCz E{(const bf16_t*)(ws + WS_U), (bf16_t*)(ws + WS_Z), ssq, cw};
        pg8::gemm_phase<EpiCz>(lds, g, S, E, wave);
    }
    SEAM();
    {
        pg8::Gemm g{(const bf16_t*)(ws + WS_Z), (const bf16_t*)(ws + WS_WOUT), M, D, D}; pg8::StaticOrder S; S.init(M, D, G, bx);
        EpiRes<1> E{nullptr, xb, nullptr, ssq};
        pg8::gemm_phase<EpiRes<1>, false>(lds, g, S, E, wave);
    }
    SEAM();
    {
        pg8::Gemm g{xb, (const bf16_t*)(ws + WS_GU0), M, 2 * DFF, D}; pg8::StaticOrder S; S.init(M, 2 * DFF, G, bx);
        EpiGu E{(bf16_t*)(ws + WS_ACT), ssq};
        pg8::gemm_phase<EpiGu>(lds, g, S, E, wave);
    }
    SEAM();
    {
        pg8::Gemm g{(const bf16_t*)(ws + WS_ACT), (const bf16_t*)(ws + WS_DN0), M, D, DFF}; pg8::StaticOrder S; S.init(M, D, G, bx);
        EpiRes<1> E{nullptr, xb, nullptr, ssq};
        pg8::gemm_phase<EpiRes<1>, false>(lds, g, S, E, wave);
    }
    SEAM();
    {
        pg8::Gemm g{xb, (const bf16_t*)(ws + WS_WQKV), M, NQKV, D}; pg8::StaticOrder S; S.init(M, NQKV, G, bx);
        EpiQkv E{(bf16_t*)(ws + WS_Q), (bf16_t*)(ws + WS_K), (bf16_t*)(ws + WS_VT), ssq, a.q_gain, a.k_gain};
        pg8::gemm_phase<EpiQkv>(lds, g, S, E, wave);
    }
    SEAM();
    attn_phase(a, lds, bx, G, wave);
    SEAM();
    {
        pg8::Gemm g{(const bf16_t*)(ws + WS_ATT), (const bf16_t*)(ws + WS_WO), M, D, D}; pg8::StaticOrder S; S.init(M, D, G, bx);
        EpiRes<1> E{nullptr, xb, nullptr, ssq};
        pg8::gemm_phase<EpiRes<1>, false>(lds, g, S, E, wave);
    }
    SEAM();
    {
        pg8::Gemm g{xb, (const bf16_t*)(ws + WS_GU1), M, 2 * DFF, D}; pg8::StaticOrder S; S.init(M, 2 * DFF, G, bx);
        EpiGu E{(bf16_t*)(ws + WS_ACT), ssq};
        pg8::gemm_phase<EpiGu>(lds, g, S, E, wave);
    }
    SEAM();
    {
        pg8::Gemm g{(const bf16_t*)(ws + WS_ACT), (const bf16_t*)(ws + WS_DN1), M, D, DFF}; pg8::StaticOrder S; S.init(M, D, G, bx);
        EpiRes<2> E{nullptr, xb, a.out, nullptr};
        pg8::gemm_phase<EpiRes<2>, false>(lds, g, S, E, wave);
    }
#undef SEAM
}

extern "C" void kernel_launch(void* const* d_in, const int* in_sizes, int n_in, void* d_out, int out_size, void* d_ws, size_t ws_size, hipStream_t stream) {
    static int grid = 0;
    if (grid == 0) {
        if (n_in != 13 || in_sizes[0] != M * D || out_size != M * D || ws_size < WS_END) { fprintf(stderr, "kernel_launch: unexpected shapes (n_in %d, in0 %d, out %d, ws %zu)\n", n_in, n_in > 0 ? in_sizes[0] : -1, out_size, ws_size); grid = -1; return; }
        int dev = 0, cus = 0, per_cu = 0;
        if (hipGetDevice(&dev) != hipSuccess || hipDeviceGetAttribute(&cus, hipDeviceAttributeMultiprocessorCount, dev) != hipSuccess) { grid = -1; return; }
        if (hipFuncSetAttribute((const void*)fwd_kernel, hipFuncAttributeMaxDynamicSharedMemorySize, LDS_BYTES) != hipSuccess) { fprintf(stderr, "kernel_launch: hipFuncSetAttribute failed\n"); grid = -1; return; }
        if (hipOccupancyMaxActiveBlocksPerMultiprocessor(&per_cu, (const void*)fwd_kernel, NWAVES * 64, LDS_BYTES) != hipSuccess || per_cu < 1) { fprintf(stderr, "kernel_launch: occupancy query gave %d\n", per_cu); per_cu = 1; }
        (void)hipGetLastError();
        grid = cus * 1;
    }
    if (grid < 0) return;
    if (hipMemsetAsync(d_ws, 0, 16384, stream) != hipSuccess) { fprintf(stderr, "kernel_launch: hipMemsetAsync failed\n"); return; }
    Args a{};
    a.x = (const float*)d_in[0]; a.conv_w_in = (const float*)d_in[1]; a.conv_w = (const float*)d_in[2]; a.conv_w_out = (const float*)d_in[3];
    a.w_qkv = (const float*)d_in[4]; a.q_gain = (const float*)d_in[5]; a.k_gain = (const float*)d_in[6]; a.sinks = (const float*)d_in[7];
    a.w_o = (const float*)d_in[8]; a.norm_mixer = (const float*)d_in[9]; a.norm_ffn = (const float*)d_in[10]; a.w_gu = (const float*)d_in[11]; a.w_dn = (const float*)d_in[12];
    a.out = (float*)d_out; a.ws = (unsigned char*)d_ws;
    a.ph_lo = 0; a.ph_hi = 11;
    void* args[] = {&a};
    hipError_t e = hipLaunchCooperativeKernel((const void*)fwd_kernel, dim3(grid), dim3(NWAVES * 64), args, LDS_BYTES, stream);
    if (e != hipSuccess) fprintf(stderr, "cooperative launch failed: %s (grid %d)\n", hipGetErrorString(e), grid);
}
```

```cpp
#include <hip/hip_runtime.h>
#include <hip/hip_cooperative_groups.h>
#include <cstdio>
#include <cstdint>
namespace cg = cooperative_groups;


#define LAS __attribute__((address_space(3)))
typedef unsigned short bf16_t;
typedef short bf16x8 __attribute__((ext_vector_type(8)));
typedef short s16x4 __attribute__((ext_vector_type(4)));
typedef float f32x4 __attribute__((ext_vector_type(4)));
typedef float f32x16 __attribute__((ext_vector_type(16)));
typedef unsigned u32x4 __attribute__((ext_vector_type(4)));
typedef unsigned u32x2 __attribute__((ext_vector_type(2)));

constexpr int M = 65536, D = 1024, DFF = 2816, SEQ = 2048, NQKV = 1536;
constexpr float EPS = 1e-6f, LOG2E = 1.4426950408889634f;

__device__ __forceinline__ unsigned cvt_pk_bf16(float lo, float hi) { unsigned r; asm volatile("v_cvt_pk_bf16_f32 %0, %1, %2" : "=v"(r) : "v"(lo), "v"(hi)); return r; }
__device__ __forceinline__ int lane_id() { int l; asm volatile("v_mbcnt_lo_u32_b32 %0, -1, 0\n\tv_mbcnt_hi_u32_b32 %0, -1, %0" : "=v"(l)); return l; }
__device__ __forceinline__ float bf_lo(unsigned w) { return __builtin_bit_cast(float, w << 16); }
__device__ __forceinline__ float bf_hi(unsigned w) { return __builtin_bit_cast(float, w & 0xffff0000u); }

namespace pg8 {
constexpr int BM = 256, BK = 64, HALF = 128, HTB = HALF * BK * 2, STAGE_BYTES = 8 * HTB, NXCD = 8, WGM = 8;
__host__ __device__ __forceinline__ int lds_byte(int r, int c) { const int st = (r >> 4) * 2 + (c >> 5), rr = r & 15, cc = c & 31, ob = rr * 64 + cc * 2; return st * 1024 + (ob ^ (((ob >> 9) & 1) << 5)); }
__host__ __device__ __forceinline__ void stage_rc(int b, int& R, int& C) { const int st = b / 1024, sb = b % 1024, swz = sb ^ (((sb >> 9) & 1) << 5); R = (st >> 1) * 16 + swz / 64; C = (st & 1) * 32 + (swz % 64) / 2; }
__host__ __device__ __forceinline__ int perm32(int rho) { const int n = rho >> 4, i = rho & 15; return 8 * (i >> 2) + 4 * n + (i & 3); }

struct Unit { int pm, pn; };
struct Gemm { const bf16_t* A; const bf16_t* Bt; int M, N, K; };

struct StaticOrder {
    int nM, nN, nwg, G, c;
    __host__ __device__ void init(int M_, int N_, int G_, int c_) { nM = M_ / BM; nN = N_ / BM; nwg = nM * nN; G = G_; c = c_; }
    __host__ __device__ bool next(int i, Unit& u) const {
        const long L = (long)i * G + c; if (L >= nwg) return false;
        int wgid = (int)L; { const int q = nwg / NXCD, r = nwg % NXCD, xcd = wgid % NXCD, off = wgid / NXCD; wgid = (xcd < r ? xcd * (q + 1) : r * (q + 1) + (xcd - r) * q) + off; }
        const int nig = WGM * nN, gid = wgid / nig, fm = gid * WGM, gsz = (nM - fm) < WGM ? (nM - fm) : WGM;
        u.pm = fm + ((wgid % nig) % gsz); u.pn = (wgid % nig) / gsz; return true;
    }
};

template <class Epi, bool ALIGN_EPI = true>
__device__ __forceinline__ void gemm_phase(LAS unsigned char* lds, const Gemm g, const StaticOrder& S, const Epi& E, int wid) {
    const int lane = lane_id(), tid = wid * 64 + lane, wr = wid >> 2, wc = wid & 3, fr = lane & 15, fq = lane >> 4;
    const int K = g.K, nt = K / BK;
    unsigned voffA[2], voffB[2];
#pragma unroll
    for (int i = 0; i < 2; ++i) { int R, C; stage_rc(tid * 16 + i * 8192, R, C); const int Rb = Epi::PERM ? ((R & ~31) + perm32(R & 31)) : R;
        voffA[i] = (unsigned)(R * K + C) * 2u; voffB[i] = (unsigned)(Rb * K + C) * 2u; }
    const size_t kstep = (size_t)(BK * 2);
    const size_t hstep = (size_t)HALF * K * 2;
    const size_t tstep = 2 * hstep;
    const unsigned ldsw = (unsigned)wid * 1024u;
    const int aoff = lds_byte(wr * 64 + fr, fq * 8), boff = lds_byte(wc * 32 + fr, fq * 8);
#define PG8_SA(b, h) (((b) * 2 + (h)) * HTB)
#define PG8_SB(b, h) ((4 + (b) * 2 + (h)) * HTB)
#define PG8_STAGE(bufoff, gbase, voff) do { _Pragma("unroll") for (int _i = 0; _i < 2; ++_i) \
        __builtin_amdgcn_global_load_lds((const unsigned*)((const char*)(gbase) + (voff)[_i]), (LAS unsigned*)(lds + (bufoff) + ldsw + _i * 8192), 16, 0, 0); } while (0)
#define PG8_LDA(dst, b, h) do { _Pragma("unroll") for (int m = 0; m < 4; ++m) _Pragma("unroll") for (int k = 0; k < 2; ++k) dst[m][k] = *(const LAS bf16x8*)(lds + PG8_SA(b, h) + aoff + m * 2048 + k * 1024); } while (0)
#define PG8_LDB(dst, b, h) do { _Pragma("unroll") for (int n = 0; n < 2; ++n) _Pragma("unroll") for (int k = 0; k < 2; ++k) dst[n][k] = *(const LAS bf16x8*)(lds + PG8_SB(b, h) + boff + n * 2048 + k * 1024); } while (0)
#define PG8_MMA(ai, bj, At, Bt) do { __builtin_amdgcn_s_setprio(1); _Pragma("unroll") for (int m = 0; m < 4; ++m) _Pragma("unroll") for (int n = 0; n < 2; ++n) _Pragma("unroll") for (int k = 0; k < 2; ++k) \
        acc[ai][bj][m][n] = __builtin_amdgcn_mfma_f32_16x16x32_bf16(Bt[n][k], At[m][k], acc[ai][bj][m][n], 0, 0, 0); __builtin_amdgcn_s_setprio(0); } while (0)
#define PG8_WAIT_V(n) asm volatile("s_waitcnt vmcnt(" #n ")" ::: "memory")
#define PG8_WAIT_L(n) asm volatile("s_waitcnt lgkmcnt(" #n ")" ::: "memory")
#define PG8_BAR __builtin_amdgcn_s_barrier()
#define PG8_SCHED __builtin_amdgcn_sched_barrier(0)
    Unit cur, nxt; int ui = 0;
    if (!S.next(0, cur)) return;
    f32x4 acc[2][2][4][2];
    E.init_acc(acc, cur, wr, wc, fr, fq);
    int rpm = -1, rbuf = 0;
    bf16x8 At[4][2], B0[2][2], B1[2][2];
    const char* cA = (const char*)g.A + (size_t)cur.pm * tstep; const char* cB = (const char*)g.Bt + (size_t)cur.pn * tstep;
    PG8_STAGE(PG8_SB(0, 0), cB, voffB); PG8_STAGE(PG8_SB(0, 1), cB + hstep, voffB); PG8_STAGE(PG8_SA(0, 0), cA, voffA); PG8_STAGE(PG8_SA(0, 1), cA + hstep, voffA);
    if (wr == 1) PG8_BAR;
    PG8_WAIT_V(2); PG8_BAR;
    PG8_STAGE(PG8_SB(1, 0), cB + kstep, voffB); PG8_STAGE(PG8_SA(1, 0), cA + kstep, voffA); PG8_STAGE(PG8_SB(1, 1), cB + hstep + kstep, voffB);
    PG8_WAIT_V(6); PG8_BAR;
    for (;;) {
        const bool has_next = S.next(ui + 1, nxt);
        const char* nA = has_next ? (const char*)g.A + (size_t)nxt.pm * tstep : cA; const char* nB = has_next ? (const char*)g.Bt + (size_t)nxt.pn * tstep : cB;
        if constexpr (Epi::RSTD) { if (cur.pm != rpm) { rbuf ^= 1; rpm = cur.pm; E.fill_rstd((LAS float*)(lds + STAGE_BYTES) + rbuf * 256, cur.pm, tid); } }
        if constexpr (Epi::INIT_BASE) E.finish_init(acc);
        for (int t = 0; t < nt; t += 2) {
            const bool last = (t == nt - 2);
            const char* a1 = cA + (size_t)(t + 1) * kstep;
            const char* a2 = last ? nA : cA + (size_t)(t + 2) * kstep; const char* b2 = last ? nB : cB + (size_t)(t + 2) * kstep;
            const char* a3 = a2 + kstep; const char* b3 = b2 + kstep;
            PG8_LDB(B0, 0, 0); PG8_LDB(B1, 0, 1); PG8_SCHED; PG8_LDA(At, 0, 0); PG8_STAGE(PG8_SA(1, 1), a1 + hstep, voffA);
            PG8_WAIT_V(8); PG8_WAIT_L(0); PG8_BAR; PG8_MMA(0, 0, At, B0); PG8_MMA(0, 1, At, B1); PG8_BAR; PG8_SCHED;
            PG8_LDA(At, 0, 1); PG8_STAGE(PG8_SB(0, 0), b2, voffB); PG8_STAGE(PG8_SB(0, 1), b2 + hstep, voffB); PG8_STAGE(PG8_SA(0, 0), a2, voffA);
            PG8_WAIT_V(8); PG8_WAIT_L(0); PG8_BAR; PG8_MMA(1, 0, At, B0); PG8_MMA(1, 1, At, B1); PG8_BAR; PG8_SCHED;
            PG8_LDB(B0, 1, 0); PG8_LDB(B1, 1, 1); PG8_SCHED; PG8_LDA(At, 1, 0); PG8_STAGE(PG8_SA(0, 1), a2 + hstep, voffA);
            PG8_WAIT_V(8); PG8_WAIT_L(0); PG8_BAR; PG8_MMA(0, 0, At, B0); PG8_MMA(0, 1, At, B1); PG8_BAR; PG8_SCHED;
            PG8_LDA(At, 1, 1); PG8_STAGE(PG8_SB(1, 0), b3, voffB); PG8_STAGE(PG8_SB(1, 1), b3 + hstep, voffB); PG8_STAGE(PG8_SA(1, 0), a3, voffA);
            PG8_WAIT_V(8); PG8_WAIT_L(0); PG8_BAR; PG8_MMA(1, 0, At, B0); PG8_MMA(1, 1, At, B1); PG8_BAR; PG8_SCHED;
        }
        if constexpr (ALIGN_EPI) { if (wr == 0) PG8_BAR; }
        E(acc, cur, has_next, nxt, (const LAS float*)(lds + STAGE_BYTES) + rbuf * 256, wr, wc, fr, fq);
        if (!has_next) break;
        cur = nxt; cA = nA; cB = nB; ++ui;
        if constexpr (ALIGN_EPI) { if (wr == 1) PG8_BAR; }
    }
    PG8_WAIT_V(0);
    if constexpr (!ALIGN_EPI) { if (wr == 0) PG8_BAR; }
    PG8_BAR;
#undef PG8_SA
#undef PG8_SB
#undef PG8_STAGE
#undef PG8_LDA
#undef PG8_LDB
#undef PG8_MMA
#undef PG8_WAIT_V
#undef PG8_WAIT_L
#undef PG8_BAR
#undef PG8_SCHED
}
}

typedef f32x4 AccT[2][2][4][2];
__device__ __forceinline__ void zero_acc(AccT& acc) {
#pragma unroll
    for (int a = 0; a < 2; ++a)
#pragma unroll
        for (int b = 0; b < 2; ++b)
#pragma unroll
            for (int m = 0; m < 4; ++m)
#pragma unroll
                for (int n = 0; n < 2; ++n) acc[a][b][m][n] = (f32x4){0.f, 0.f, 0.f, 0.f};
}
__device__ __forceinline__ void fill_rstd_tbl(const float* ssq, LAS float* dst, int pm, int tid) {
    const int row = tid >> 1, hf = tid & 1;
    const f32x4* p = (const f32x4*)(ssq + (size_t)(pm * 256 + row) * 16 + hf * 8);
    const f32x4 a = p[0], b = p[1];
    float s = ((a[0] + a[1]) + (a[2] + a[3])) + ((b[0] + b[1]) + (b[2] + b[3]));
    s += __shfl_xor(s, 1);
    if (hf == 0) dst[row] = 1.0f / sqrtf(s * (1.0f / 1024.0f) + EPS);
}
__device__ __forceinline__ void load_rstd(const LAS float* tbl, int wr, int fr, float (&rs)[2][4]) {
#pragma unroll
    for (int ai = 0; ai < 2; ++ai)
#pragma unroll
        for (int m = 0; m < 4; ++m) rs[ai][m] = tbl[ai * 128 + wr * 64 + m * 16 + fr];
}
__device__ __forceinline__ float silu_f(float x) { return x * __builtin_amdgcn_rcpf(1.0f + __builtin_amdgcn_exp2f(-x * LOG2E)); }

struct EpiU {
    static constexpr bool PERM = true, RSTD = true, INIT_BASE = false;
    bf16_t* U; const float* ssq;
    __device__ __forceinline__ void init_acc(AccT& acc, const pg8::Unit&, int, int, int, int) const { zero_acc(acc); }
    __device__ __forceinline__ void fill_rstd(LAS float* dst, int pm, int tid) const { fill_rstd_tbl(ssq, dst, pm, tid); }
    __device__ __forceinline__ void operator()(AccT& acc, const pg8::Unit& u, bool, const pg8::Unit&, const LAS float* tbl, int wr, int wc, int fr, int fq) const {
        const int row0 = u.pm * 256 + wr * 64 + fr;
        float rs[2][4]; load_rstd(tbl, wr, fr, rs);
        const int col0 = u.pn * 128 + wc * 32 + 8 * fq;
#pragma unroll
        for (int ai = 0; ai < 2; ++ai)
#pragma unroll
            for (int m = 0; m < 4; ++m) {
                const float r2 = rs[ai][m] * rs[ai][m];
                const f32x4 v0 = acc[ai][0][m][0] * acc[ai][1][m][0] * r2, v1 = acc[ai][0][m][1] * acc[ai][1][m][1] * r2;
                u32x4 w; w.x = cvt_pk_bf16(v0[0], v0[1]); w.y = cvt_pk_bf16(v0[2], v0[3]); w.z = cvt_pk_bf16(v1[0], v1[1]); w.w = cvt_pk_bf16(v1[2], v1[3]);
                *(u32x4*)(U + (size_t)(row0 + ai * 128 + m * 16) * D + col0) = w;
            }
        zero_acc(acc);
    }
};
struct EpiCz {
    static constexpr bool PERM = true, RSTD = true, INIT_BASE = false;
    const bf16_t* U; bf16_t* Z; const float* ssq; const LAS float* cw;
    __device__ __forceinline__ void init_acc(AccT& acc, const pg8::Unit&, int, int, int, int) const { zero_acc(acc); }
    __device__ __forceinline__ void fill_rstd(LAS float* dst, int pm, int tid) const { fill_rstd_tbl(ssq, dst, pm, tid); }
    __device__ __forceinline__ static unsigned ror_(unsigned p, int n) { return n == 1 ? (unsigned)__builtin_amdgcn_update_dpp(0, (int)p, 0x121, 0xf, 0xf, true) : (unsigned)__builtin_amdgcn_update_dpp(0, (int)p, 0x122, 0xf, 0xf, true); }
    __device__ __forceinline__ static unsigned above_(unsigned prev, unsigned cur, int n) {
        const unsigned old = ror_(prev, n);
        return n == 1 ? (unsigned)__builtin_amdgcn_update_dpp((int)old, (int)cur, 0x111, 0xf, 0xf, false) : (unsigned)__builtin_amdgcn_update_dpp((int)old, (int)cur, 0x112, 0xf, 0xf, false);
    }
    __device__ __forceinline__ void operator()(AccT& acc, const pg8::Unit& u, bool, const pg8::Unit&, const LAS float* tbl, int wr, int wc, int fr, int fq) const {
        const int row0 = u.pm * 256 + wr * 64 + fr;
        const int ch0 = u.pn * 256 + wc * 32 + 8 * fq;
        u32x4 uu[2][4][2], hh[2][2];
#define CZ_LOAD(ai) do { _Pragma("unroll") for (int bj = 0; bj < 2; ++bj) { hh[ai][bj] = (u32x4){0u, 0u, 0u, 0u}; const int hr = row0 + (ai) * 128 - 16; \
            if (fr >= 14 && hr >= 0) hh[ai][bj] = *(const u32x4*)(U + (size_t)hr * D + ch0 + bj * 128); } \
        _Pragma("unroll") for (int m = 0; m < 4; ++m) _Pragma("unroll") for (int bj = 0; bj < 2; ++bj) uu[ai][m][bj] = *(const u32x4*)(U + (size_t)(row0 + (ai) * 128 + m * 16) * D + ch0 + bj * 128); } while (0)
#define CZ_GROUP(ai, m) do { const int row = row0 + (ai) * 128 + (m) * 16; const float r = rs[ai][m]; \
        _Pragma("unroll") for (int bj = 0; bj < 2; ++bj) { const LAS float* wp = cw + ch0 + bj * 128; \
            const u32x4 u0 = uu[ai][m][bj], pv = ((m) == 0) ? hh[ai][bj] : uu[ai][(m) == 0 ? 0 : (m) - 1][bj]; u32x4 u1, u2; \
            _Pragma("unroll") for (int k = 0; k < 4; ++k) { u1[k] = above_(pv[k], u0[k], 1); u2[k] = above_(pv[k], u0[k], 2); } \
            if ((ai) == 0 && (m) == 0) { const int t = row & (SEQ - 1); if (t < 1) u1 = (u32x4){0u, 0u, 0u, 0u}; if (t < 2) u2 = (u32x4){0u, 0u, 0u, 0u}; } \
            f32x4 z[2]; \
            _Pragma("unroll") for (int n = 0; n < 2; ++n) { \
                const f32x4 w0 = *(const LAS f32x4*)(wp + 4 * n), w1 = *(const LAS f32x4*)(wp + D + 4 * n), w2 = *(const LAS f32x4*)(wp + 2 * D + 4 * n); \
                const f32x4 a0 = (f32x4){bf_lo(u0[2 * n]), bf_hi(u0[2 * n]), bf_lo(u0[2 * n + 1]), bf_hi(u0[2 * n + 1])}; \
                const f32x4 a1 = (f32x4){bf_lo(u1[2 * n]), bf_hi(u1[2 * n]), bf_lo(u1[2 * n + 1]), bf_hi(u1[2 * n + 1])}; \
                const f32x4 a2 = (f32x4){bf_lo(u2[2 * n]), bf_hi(u2[2 * n]), bf_lo(u2[2 * n + 1]), bf_hi(u2[2 * n + 1])}; \
                z[n] = (acc[ai][bj][m][n] * r) * (w0 * a2 + w1 * a1 + w2 * a0); } \
            u32x4 w; w.x = cvt_pk_bf16(z[0][0], z[0][1]); w.y = cvt_pk_bf16(z[0][2], z[0][3]); w.z = cvt_pk_bf16(z[1][0], z[1][1]); w.w = cvt_pk_bf16(z[1][2], z[1][3]); \
            *(u32x4*)(Z + (size_t)row * D + ch0 + bj * 128) = w; } } while (0)
        CZ_LOAD(0);
        float rs[2][4]; load_rstd(tbl, wr, fr, rs);
        __builtin_amdgcn_sched_barrier(0);
        CZ_GROUP(0, 0); CZ_GROUP(0, 1); CZ_GROUP(0, 2);
        __builtin_amdgcn_sched_barrier(0);
        CZ_LOAD(1);
        __builtin_amdgcn_sched_barrier(0);
        CZ_GROUP(0, 3);
        CZ_GROUP(1, 0); CZ_GROUP(1, 1); CZ_GROUP(1, 2); CZ_GROUP(1, 3);
#undef CZ_LOAD
#undef CZ_GROUP
        zero_acc(acc);
    }
};
struct EpiGu {
    static constexpr bool PERM = true, RSTD = true, INIT_BASE = false;
    bf16_t* ACT; const float* ssq;
    __device__ __forceinline__ void init_acc(AccT& acc, const pg8::Unit&, int, int, int, int) const { zero_acc(acc); }
    __device__ __forceinline__ void fill_rstd(LAS float* dst, int pm, int tid) const { fill_rstd_tbl(ssq, dst, pm, tid); }
    __device__ __forceinline__ void operator()(AccT& acc, const pg8::Unit& u, bool, const pg8::Unit&, const LAS float* tbl, int wr, int wc, int fr, int fq) const {
        const int row0 = u.pm * 256 + wr * 64 + fr;
        float rs[2][4]; load_rstd(tbl, wr, fr, rs);
        const int col0 = u.pn * 128 + wc * 32 + 8 * fq;
#pragma unroll
        for (int ai = 0; ai < 2; ++ai)
#pragma unroll
            for (int m = 0; m < 4; ++m) {
                const float r = rs[ai][m], r2 = r * r, nrl = -r * LOG2E;
                f32x4 v[2];
#pragma unroll
                for (int n = 0; n < 2; ++n) {
                    const f32x4 gg = acc[ai][0][m][n], p = (gg * acc[ai][1][m][n]) * r2, t = gg * nrl;
                    f32x4 d;
#pragma unroll
                    for (int i = 0; i < 4; ++i) d[i] = __builtin_amdgcn_exp2f(t[i]);
                    d = d + 1.0f;
#pragma unroll
                    for (int i = 0; i < 4; ++i) d[i] = __builtin_amdgcn_rcpf(d[i]);
                    v[n] = p * d;
                }
                u32x4 w; w.x = cvt_pk_bf16(v[0][0], v[0][1]); w.y = cvt_pk_bf16(v[0][2], v[0][3]); w.z = cvt_pk_bf16(v[1][0], v[1][1]); w.w = cvt_pk_bf16(v[1][2], v[1][3]);
                __builtin_nontemporal_store(w, (u32x4*)(ACT + (size_t)(row0 + ai * 128 + m * 16) * DFF + col0));
            }
        zero_acc(acc);
    }
};
template <int MODE> struct EpiRes {
    static constexpr bool PERM = true, RSTD = false, INIT_BASE = true;
    const float* basef; bf16_t* xb; float* outf; float* ssq;
    __device__ __forceinline__ void fill_rstd(LAS float*, int, int) const {}
    __device__ __forceinline__ static void expand(AccT& acc, int ai, int bj, int m, const u32x4 w) {
        acc[ai][bj][m][0] = (f32x4){bf_lo(w.x), bf_hi(w.x), bf_lo(w.y), bf_hi(w.y)}; acc[ai][bj][m][1] = (f32x4){bf_lo(w.z), bf_hi(w.z), bf_lo(w.w), bf_hi(w.w)};
    }
    __device__ __forceinline__ void load_group_f32(AccT& acc, int ai, int m, size_t off) const {
#pragma unroll
        for (int bj = 0; bj < 2; ++bj)
#pragma unroll
            for (int n = 0; n < 2; ++n) acc[ai][bj][m][n] = *(const f32x4*)(basef + off + bj * 128 + 4 * n);
    }
    __device__ __forceinline__ void init_acc(AccT& acc, const pg8::Unit& u, int wr, int wc, int fr, int fq) const {
        const int row0 = u.pm * 256 + wr * 64 + fr, col0 = u.pn * 256 + wc * 32 + 8 * fq;
#pragma unroll
        for (int ai = 0; ai < 2; ++ai)
#pragma unroll
            for (int m = 0; m < 4; ++m) {
                const size_t off = (size_t)(row0 + ai * 128 + m * 16) * D + col0;
                if (MODE == 0) load_group_f32(acc, ai, m, off);
                else {
#pragma unroll
                    for (int bj = 0; bj < 2; ++bj) expand(acc, ai, bj, m, *(const u32x4*)(xb + off + bj * 128));
                }
            }
    }
    __device__ __forceinline__ void finish_init(AccT& acc) const {
        __builtin_amdgcn_sched_barrier(0);
#pragma unroll
        for (int a = 0; a < 2; ++a)
#pragma unroll
            for (int b = 0; b < 2; ++b)
#pragma unroll
                for (int m = 0; m < 4; ++m)
#pragma unroll
                    for (int n = 0; n < 2; ++n) asm volatile("" : "+v"(acc[a][b][m][n]));
    }
    __device__ __forceinline__ void operator()(AccT& acc, const pg8::Unit& u, bool has_next, const pg8::Unit& nx, const LAS float*, int wr, int wc, int fr, int fq) const {
        const int row0 = u.pm * 256 + wr * 64 + fr, col0 = u.pn * 256 + wc * 32 + 8 * fq;
        const int nrow0 = nx.pm * 256 + wr * 64 + fr, ncol0 = nx.pn * 256 + wc * 32 + 8 * fq;
        u32x4 t[2][4][2];
        if (MODE != 0 && has_next) {
#pragma unroll
            for (int ai = 0; ai < 2; ++ai)
#pragma unroll
                for (int m = 0; m < 4; ++m) {
                    const size_t noff = (size_t)(nrow0 + ai * 128 + m * 16) * D + ncol0;
#pragma unroll
                    for (int bj = 0; bj < 2; ++bj) t[ai][m][bj] = *(const u32x4*)(xb + noff + bj * 128);
                }
            __builtin_amdgcn_sched_barrier(0);
        }
#pragma unroll
        for (int ai = 0; ai < 2; ++ai)
#pragma unroll
            for (int m = 0; m < 4; ++m) {
                const size_t off = (size_t)(row0 + ai * 128 + m * 16) * D + col0; float s = 0.f;
#pragma unroll
                for (int bj = 0; bj < 2; ++bj) {
                    const f32x4 o0 = acc[ai][bj][m][0], o1 = acc[ai][bj][m][1];
                    if (MODE == 2) { __builtin_nontemporal_store(o0, (f32x4*)(outf + off + bj * 128)); __builtin_nontemporal_store(o1, (f32x4*)(outf + off + bj * 128 + 4)); }
                    else {
                        s += ((o0[0] * o0[0] + o0[1] * o0[1]) + (o0[2] * o0[2] + o0[3] * o0[3])) + ((o1[0] * o1[0] + o1[1] * o1[1]) + (o1[2] * o1[2] + o1[3] * o1[3]));
                        u32x4 w; w.x = cvt_pk_bf16(o0[0], o0[1]); w.y = cvt_pk_bf16(o0[2], o0[3]); w.z = cvt_pk_bf16(o1[0], o1[1]); w.w = cvt_pk_bf16(o1[2], o1[3]);
                        *(u32x4*)(xb + off + bj * 128) = w;
                    }
                }
                if (MODE != 2) {
                    s += __shfl_xor(s, 16); s += __shfl_xor(s, 32);
                    if (fq == 0) ssq[(size_t)(row0 + ai * 128 + m * 16) * 16 + u.pn * 4 + wc] = s;
                }
                if (MODE == 0) { if (has_next) load_group_f32(acc, ai, m, (size_t)(nrow0 + ai * 128 + m * 16) * D + ncol0); }
            }
        if (MODE != 0 && has_next) {
            __builtin_amdgcn_sched_barrier(0);
#pragma unroll
            for (int ai = 0; ai < 2; ++ai)
#pragma unroll
                for (int m = 0; m < 4; ++m)
#pragma unroll
                    for (int bj = 0; bj < 2; ++bj) expand(acc, ai, bj, m, t[ai][m][bj]);
        }
    }
};
struct EpiQkv {
    static constexpr bool PERM = true, RSTD = true, INIT_BASE = false;
    bf16_t* Q; bf16_t* Kb; bf16_t* Vt; const float* ssq; const float* qg; const float* kg;
    __device__ __forceinline__ void init_acc(AccT& acc, const pg8::Unit&, int, int, int, int) const { zero_acc(acc); }
    __device__ __forceinline__ void fill_rstd(LAS float* dst, int pm, int tid) const { fill_rstd_tbl(ssq, dst, pm, tid); }
    __device__ __forceinline__ void operator()(AccT& acc, const pg8::Unit& u, bool, const pg8::Unit&, const LAS float* tbl, int wr, int wc, int fr, int fq) const {
        const int row0 = u.pm * 256 + wr * 64 + fr;
        float rs[2][4]; load_rstd(tbl, wr, fr, rs);
        if (u.pn < 5) {
            const bool isq = u.pn < 4;
            const float* gain = isq ? qg : kg; const float sc = isq ? 0.125f * LOG2E : 1.0f;
            bf16_t* dst = isq ? Q + (4 * u.pn + wc) * 64 : Kb + wc * 64; const int ld = isq ? 1024 : 256;
            f32x4 gv[2][2];
#pragma unroll
            for (int bj = 0; bj < 2; ++bj)
#pragma unroll
                for (int n = 0; n < 2; ++n) gv[bj][n] = *(const f32x4*)(gain + 32 * bj + 8 * fq + 4 * n) * sc;
#pragma unroll
            for (int ai = 0; ai < 2; ++ai)
#pragma unroll
                for (int m = 0; m < 4; ++m) {
                    const float r = rs[ai][m]; float ss = 0.f; f32x4 v[2][2];
#pragma unroll
                    for (int bj = 0; bj < 2; ++bj)
#pragma unroll
                        for (int n = 0; n < 2; ++n) { v[bj][n] = acc[ai][bj][m][n] * r; const f32x4 t = v[bj][n]; ss += (t[0] * t[0] + t[1] * t[1]) + (t[2] * t[2] + t[3] * t[3]); }
                    ss += __shfl_xor(ss, 16); ss += __shfl_xor(ss, 32);
                    const float rq = 1.0f / sqrtf(ss * (1.0f / 64.0f) + EPS);
                    bf16_t* rowp = dst + (size_t)(row0 + ai * 128 + m * 16) * ld + 8 * fq;
#pragma unroll
                    for (int bj = 0; bj < 2; ++bj) { const f32x4 o0 = v[bj][0] * rq * gv[bj][0], o1 = v[bj][1] * rq * gv[bj][1];
                        u32x4 w; w.x = cvt_pk_bf16(o0[0], o0[1]); w.y = cvt_pk_bf16(o0[2], o0[3]); w.z = cvt_pk_bf16(o1[0], o1[1]); w.w = cvt_pk_bf16(o1[2], o1[3]); *(u32x4*)(rowp + 32 * bj) = w; }
                }
        } else {
#pragma unroll
            for (int ai = 0; ai < 2; ++ai)
#pragma unroll
                for (int m = 0; m < 4; ++m) {
                    const int row = row0 + ai * 128 + m * 16; const float r = rs[ai][m];
                    bf16_t* p = Vt + ((size_t)((row >> 11) * 4 + wc) * 64 + 8 * fq) * SEQ + (row & (SEQ - 1));
                    const int par = fr & 1, hi2 = (fr >> 1) & 1;
#pragma unroll
                    for (int bj = 0; bj < 2; ++bj)
#pragma unroll
                        for (int n = 0; n < 2; ++n) { const f32x4 o = acc[ai][bj][m][n] * r;
                            unsigned wd[2];
#pragma unroll
                            for (int i = 0; i < 4; i += 2) {
                                const unsigned w = cvt_pk_bf16(o[i], o[i + 1]);
                                const unsigned wp = (unsigned)__builtin_amdgcn_update_dpp(0, (int)w, 0xB1, 0xf, 0xf, true);
                                wd[i >> 1] = par ? ((wp >> 16) | (w & 0xffff0000u)) : ((w & 0xffffu) | (wp << 16));
                            }
                            const unsigned snd = hi2 ? wd[0] : wd[1], keep = hi2 ? wd[1] : wd[0];
                            const unsigned rcv = (unsigned)__builtin_amdgcn_update_dpp(0, (int)snd, 0x4E, 0xf, 0xf, true);
                            u32x2 w8; w8.x = hi2 ? rcv : keep; w8.y = hi2 ? keep : rcv;
                            *(u32x2*)(p - (fr & 3) + (size_t)(32 * bj + 4 * n + 2 * hi2 + par) * SEQ) = w8; }
                }
        }
        zero_acc(acc);
    }
};

constexpr size_t MiB = 1u << 20;
constexpr size_t WS_WIN = 1 * MiB, WS_WOUT = 7 * MiB, WS_GU0 = 9 * MiB, WS_DN0 = 20 * MiB, WS_WQKV = 26 * MiB, WS_WO = 29 * MiB, WS_GU1 = 31 * MiB, WS_DN1 = 42 * MiB;
constexpr size_t WS_SSQ = 48 * MiB;
constexpr size_t WS_XB = 64 * MiB;
constexpr size_t WS_R = 192 * MiB;
constexpr size_t WS_U = WS_R, WS_C = WS_R + 128 * MiB, WS_Z = WS_R + 256 * MiB;
constexpr size_t WS_ACT = WS_R;
constexpr size_t WS_Q = WS_R, WS_K = WS_R + 128 * MiB, WS_VT = WS_R + 160 * MiB, WS_ATT = WS_R + 192 * MiB;
constexpr size_t WS_END = WS_R + 384 * MiB;

constexpr int CW_OFF = 131072 + 2048;
constexpr int MISC_OFF = 147456 - 256;
constexpr int LDS_BYTES = 147456;
constexpr int NWAVES = 8;

__device__ __forceinline__ int map_row(int kind, int n0) {
    if (kind == 1) { if (n0 < 1024) return 256 * (n0 >> 7) + (n0 & 127); if (n0 < 2048) return 2048 + (n0 - 1024); const int n = n0 - 2048; return 256 * (n >> 7) + 128 + (n & 127); }
    if (kind == 2) { if (n0 < DFF) return 256 * (n0 >> 7) + (n0 & 127); const int n = n0 - DFF; return 256 * (n >> 7) + 128 + (n & 127); }
    if (kind == 3) { if (n0 < 1024) { const int hd = n0 >> 6, d0 = n0 & 63; return 256 * (hd >> 2) + 128 * (d0 >> 5) + 32 * (hd & 3); }
        const int n = n0 - 1024, t = n >> 8, n2 = n & 255, wc = n2 >> 6, d0 = n2 & 63; return 1024 + 256 * t + 128 * (d0 >> 5) + 32 * wc; }
    return n0;
}
__device__ __forceinline__ void p0_item(const float* W, int K, int N, bf16_t* WT, const float* gain, int kind, LAS float* scr, int item, int lane) {
    const int nblk = N / 32, kb = item / nblk, nb = item % nblk, k0 = 64 * kb, n0 = 32 * nb;
#pragma unroll 8
    for (int i = 0; i < 32; ++i) { const int kk = 2 * i + (lane >> 5); const float gsc = gain ? gain[k0 + kk] : 1.0f; scr[kk * 33 + (lane & 31)] = W[(size_t)(k0 + kk) * N + n0 + (lane & 31)] * gsc; }
    asm volatile("s_waitcnt lgkmcnt(0)" ::: "memory");
    const int c = lane & 7; const int r0 = map_row(kind, n0);
#pragma unroll
    for (int j = 0; j < 4; ++j) { const int n = (lane >> 3) + 8 * j; const LAS float* s = scr + (8 * c) * 33 + n;
        u32x4 o; o.x = cvt_pk_bf16(s[0 * 33], s[1 * 33]); o.y = cvt_pk_bf16(s[2 * 33], s[3 * 33]); o.z = cvt_pk_bf16(s[4 * 33], s[5 * 33]); o.w = cvt_pk_bf16(s[6 * 33], s[7 * 33]);
        *(u32x4*)(WT + (size_t)(r0 + n) * K + k0 + 8 * c) = o; }
    asm volatile("s_waitcnt lgkmcnt(0)" ::: "memory");
}
__device__ __forceinline__ float wave_sum(float v) {
#pragma unroll
    for (int o = 1; o < 64; o <<= 1) v += __shfl_xor(v, o);
    return v;
}

struct Args {
    const float* x; const float* conv_w_in; const float* conv_w; const float* conv_w_out; const float* w_qkv; const float* q_gain; const float* k_gain; const float* sinks;
    const float* w_o; const float* norm_mixer; const float* norm_ffn; const float* w_gu; const float* w_dn;
    float* out; unsigned char* ws; int ph_lo, ph_hi;
};

__device__ __forceinline__ void p0_prologue(const Args& a, LAS unsigned char* lds, int gw, int NGW, int lane, int wave) {
    LAS float* scr = (LAS float*)(lds + wave * 16384);
    unsigned char* ws = a.ws;
    constexpr int I_WIN = 16 * 96, I_SQ = 16 * 32, I_GU = 16 * 176, I_DN = 44 * 32, I_QKV = 16 * 48;
    constexpr int NITEMS = I_WIN + I_SQ + I_GU + I_DN + I_QKV + I_SQ + I_GU + I_DN;
    for (int it = gw; it < NITEMS; it += NGW) {
        int r = it;
        if (r < I_WIN) { p0_item(a.conv_w_in, D, 3 * D, (bf16_t*)(ws + WS_WIN), a.norm_mixer, 1, scr, r, lane); continue; } r -= I_WIN;
        if (r < I_SQ) { p0_item(a.conv_w_out, D, D, (bf16_t*)(ws + WS_WOUT), nullptr, 0, scr, r, lane); continue; } r -= I_SQ;
        if (r < I_GU) { p0_item(a.w_gu, D, 2 * DFF, (bf16_t*)(ws + WS_GU0), a.norm_ffn, 2, scr, r, lane); continue; } r -= I_GU;
        if (r < I_DN) { p0_item(a.w_dn, DFF, D, (bf16_t*)(ws + WS_DN0), nullptr, 0, scr, r, lane); continue; } r -= I_DN;
        if (r < I_QKV) { p0_item(a.w_qkv, D, NQKV, (bf16_t*)(ws + WS_WQKV), a.norm_mixer + D, 3, scr, r, lane); continue; } r -= I_QKV;
        if (r < I_SQ) { p0_item(a.w_o, D, D, (bf16_t*)(ws + WS_WO), nullptr, 0, scr, r, lane); continue; } r -= I_SQ;
        if (r < I_GU) { p0_item(a.w_gu + (size_t)D * 2 * DFF, D, 2 * DFF, (bf16_t*)(ws + WS_GU1), a.norm_ffn + D, 2, scr, r, lane); continue; } r -= I_GU;
        p0_item(a.w_dn + (size_t)DFF * D, DFF, D, (bf16_t*)(ws + WS_DN1), nullptr, 0, scr, r, lane);
    }
    bf16_t* xb = (bf16_t*)(ws + WS_XB); float* ssq = (float*)(ws + WS_SSQ);
    for (int m0 = gw; m0 < M; m0 += 2 * NGW) {
        const int m1 = m0 + NGW; const bool two = m1 < M;
        f32x4 v[2][4];
#pragma unroll
        for (int q = 0; q < 2; ++q) { const int m = q ? (two ? m1 : m0) : m0; const f32x4* xr = (const f32x4*)(a.x + (size_t)m * D) + 2 * lane;
#pragma unroll
            for (int j = 0; j < 2; ++j) { v[q][2 * j] = xr[128 * j]; v[q][2 * j + 1] = xr[128 * j + 1]; } }
#pragma unroll
        for (int q = 0; q < 2; ++q) {
            if (q == 1 && !two) break;
            const int m = q ? m1 : m0; float s = 0.f;
#pragma unroll
            for (int j = 0; j < 4; ++j) s += (v[q][j][0] * v[q][j][0] + v[q][j][1] * v[q][j][1]) + (v[q][j][2] * v[q][j][2] + v[q][j][3] * v[q][j][3]);
            s = wave_sum(s);
            u32x4* o16 = (u32x4*)(xb + (size_t)m * D) + lane;
#pragma unroll
            for (int j = 0; j < 2; ++j) { u32x4 w; w.x = cvt_pk_bf16(v[q][2 * j][0], v[q][2 * j][1]); w.y = cvt_pk_bf16(v[q][2 * j][2], v[q][2 * j][3]); w.z = cvt_pk_bf16(v[q][2 * j + 1][0], v[q][2 * j + 1][1]); w.w = cvt_pk_bf16(v[q][2 * j + 1][2], v[q][2 * j + 1][3]); o16[64 * j] = w; }
            if (lane < 16) ssq[(size_t)m * 16 + lane] = (lane == 0) ? s : 0.f;
        }
    }
}

constexpr int AT_KS = 0, AT_KSTR = 144, AT_VS = 256 * AT_KSTR, AT_VSTR = 520, AT_L = AT_VS + 64 * AT_VSTR, AT_STG = AT_L + 1024;
__device__ __forceinline__ void attn_phase(const Args& a, LAS unsigned char* lds, int cu, int G, int wid) {
    const bf16_t* Q = (const bf16_t*)(a.ws + WS_Q); const bf16_t* Kb = (const bf16_t*)(a.ws + WS_K); const bf16_t* Vt = (const bf16_t*)(a.ws + WS_VT); bf16_t* O = (bf16_t*)(a.ws + WS_ATT);
    const int lane = lane_id(), tid = wid * 64 + lane, r = lane & 31, h = lane >> 5;
    LAS float* lw = (LAS float*)(lds + AT_L) + wid * 32;
    bf16x8 qn[4];
    if (cu < 32 * 16 * 4) { const int kvh_ = cu & 3, nb_ = (cu >> 2) & 15, b_ = cu >> 6; const size_t qt_ = (size_t)b_ * SEQ + nb_ * 128 + 32 * (2 * (wid & 1));
#pragma unroll
      for (int s = 0; s < 4; ++s) qn[s] = *(const bf16x8*)(Q + (qt_ + r) * D + (4 * kvh_ + (wid >> 1)) * 64 + 16 * s + 8 * h); }
    for (int ui = cu; ui < 32 * 16 * 4; ui += G) {
        const int kvh = ui & 3, nb = (ui >> 2) & 15, b = ui >> 6;
        const int tok0 = b * SEQ + (nb - 1) * 128;
#pragma unroll
        for (int i = 0; i < 4; ++i) {
            const int c = tid + 512 * i, row = c >> 3, chk = c & 7;
            u32x4 v = (u32x4){0u, 0u, 0u, 0u};
            if (nb > 0 || row >= 128) v = *(const u32x4*)(Kb + (size_t)(tok0 + row) * 256 + kvh * 64 + chk * 8);
            *(LAS u32x4*)(lds + AT_KS + row * AT_KSTR + chk * 16) = v;
        }
#pragma unroll
        for (int i = 0; i < 4; ++i) {
            const int c = tid + 512 * i, d = c >> 5, chk = c & 31;
            u32x4 v = (u32x4){0u, 0u, 0u, 0u};
            if (nb > 0 || chk >= 16) v = *(const u32x4*)(Vt + ((size_t)(b * 4 + kvh) * 64 + d) * SEQ + (nb - 1) * 128 + chk * 8);
            LAS u32x2* p = (LAS u32x2*)(lds + AT_VS + d * AT_VSTR + chk * 16);
            p[0] = (u32x2){v.x, v.y}; p[1] = (u32x2){v.z, v.w};
        }
        __syncthreads();
        const int g = wid >> 1, hq = 4 * kvh + g;
        const float slope2 = exp2f(-0.5f * (float)(hq + 1)) * LOG2E, sink2 = a.sinks[hq] * LOG2E;
        for (int sbi = 0; sbi < 2; ++sbi) {
            const int sb = 2 * (wid & 1) + sbi;
            const size_t qtok = (size_t)b * SEQ + nb * 128 + 32 * sb;
            bf16x8 qf[4];
#pragma unroll
            for (int s = 0; s < 4; ++s) qf[s] = qn[s];
            {
                const int nu = (sbi == 0) ? ui : ui + G;
                if (nu < 32 * 16 * 4) { const int kvh_ = nu & 3, nb_ = (nu >> 2) & 15, b_ = nu >> 6; const size_t qt_ = (size_t)b_ * SEQ + nb_ * 128 + 32 * (2 * (wid & 1) + (sbi ^ 1));
#pragma unroll
                    for (int s = 0; s < 4; ++s) qn[s] = *(const bf16x8*)(Q + (qt_ + r) * D + (4 * kvh_ + (wid >> 1)) * 64 + 16 * s + 8 * h); }
            }
            f32x16 st[5];
#pragma unroll
            for (int kt = 0; kt < 5; ++kt) {
                const int kb = 32 * (sb + kt);
                st[kt] = (f32x16){0.f, 0.f, 0.f, 0.f, 0.f, 0.f, 0.f, 0.f, 0.f, 0.f, 0.f, 0.f, 0.f, 0.f, 0.f, 0.f};
#pragma unroll
                for (int s = 0; s < 4; ++s) {
                    const bf16x8 kf = *(const LAS bf16x8*)(lds + AT_KS + (kb + r) * AT_KSTR + (16 * s + 8 * h) * 2);
                    st[kt] = __builtin_amdgcn_mfma_f32_32x32x16_bf16(kf, qf[s], st[kt], 0, 0, 0);
                }
                __builtin_amdgcn_sched_barrier(0);
            }
            int rr = r, hh = h; asm volatile("" : "+v"(rr), "+v"(hh));
            const int basei = rr + 128 - 4 * hh; const float nsb = -slope2 * (float)basei;
            float mx = sink2;
#pragma unroll
            for (int kt = 0; kt < 5; ++kt) {
                const bool tv = (nb > 0) || (sb + kt >= 4);
#pragma unroll
                for (int i = 0; i < 16; ++i) {
                    const int c = 32 * kt + (i & 3) + 8 * (i >> 2);
                    float v = (st[kt][i] + slope2 * (float)c) + nsb;
                    bool valid = tv;
                    if (kt == 0) valid = valid && (basei - c < 128);
                    if (kt == 4) valid = valid && (basei - c >= 0);
                    v = valid ? v : -INFINITY;
                    st[kt][i] = v; mx = fmaxf(mx, v);
                }
            }
            mx = fmaxf(mx, __shfl_xor(mx, 32));
            float l = 0.f;
#pragma unroll
            for (int kt = 0; kt < 5; ++kt)
#pragma unroll
                for (int i = 0; i < 16; ++i) { const float p = __builtin_amdgcn_exp2f(st[kt][i] - mx); st[kt][i] = p; l += p; }
            l += __shfl_xor(l, 32);
            l += __builtin_amdgcn_exp2f(sink2 - mx);
            if (h == 0) lw[r] = l;
            f32x16 o[2];
            o[0] = (f32x16){0.f, 0.f, 0.f, 0.f, 0.f, 0.f, 0.f, 0.f, 0.f, 0.f, 0.f, 0.f, 0.f, 0.f, 0.f, 0.f}; o[1] = o[0];
#pragma unroll
            for (int kt = 0; kt < 5; ++kt)
#pragma unroll
                for (int s2 = 0; s2 < 2; ++s2) {
                    u32x4 pw; pw.x = cvt_pk_bf16(st[kt][8 * s2 + 0], st[kt][8 * s2 + 1]); pw.y = cvt_pk_bf16(st[kt][8 * s2 + 2], st[kt][8 * s2 + 3]);
                    pw.z = cvt_pk_bf16(st[kt][8 * s2 + 4], st[kt][8 * s2 + 5]); pw.w = cvt_pk_bf16(st[kt][8 * s2 + 6], st[kt][8 * s2 + 7]);
                    const bf16x8 pa = __builtin_bit_cast(bf16x8, pw);
                    const int kb = 32 * (sb + kt) + 16 * s2 + 4 * h;
#pragma unroll
                    for (int c = 0; c < 2; ++c) {
                        const LAS unsigned char* vp = lds + AT_VS + (32 * c + r) * AT_VSTR + kb * 2;
                        const u32x2 lo = *(const LAS u32x2*)vp, hi = *(const LAS u32x2*)(vp + 16);
                        const u32x4 vw = (u32x4){lo.x, lo.y, hi.x, hi.y};
                        o[c] = __builtin_amdgcn_mfma_f32_32x32x16_bf16(pa, __builtin_bit_cast(bf16x8, vw), o[c], 0, 0, 0);
                    }
                    __builtin_amdgcn_sched_barrier(0);
                }
            asm volatile("s_waitcnt lgkmcnt(0)" ::: "memory");
            LAS bf16_t* stg = (LAS bf16_t*)(lds + AT_STG) + wid * 2048;
#pragma unroll
            for (int i = 0; i < 16; ++i) {
                const int qr = (i & 3) + 8 * (i >> 2) + 4 * h;
                const float li = __builtin_amdgcn_rcpf(lw[qr]);
                const unsigned w = cvt_pk_bf16(o[0][i] * li, o[1][i] * li);
                stg[qr * 64 + r] = (bf16_t)(w & 0xffffu); stg[qr * 64 + 32 + r] = (bf16_t)(w >> 16);
            }
            asm volatile("s_waitcnt lgkmcnt(0)" ::: "memory");
#pragma unroll
            for (int j = 0; j < 4; ++j) {
                const int row = j * 8 + (lane >> 3), ch = lane & 7;
                const u32x4 v = *(const LAS u32x4*)(stg + row * 64 + ch * 8);
                *(u32x4*)(O + (qtok + row) * D + hq * 64 + ch * 8) = v;
            }
            asm volatile("s_waitcnt lgkmcnt(0)" ::: "memory");
        }
        __syncthreads();
    }
}

#define XB_TMO      128
#define XB_XCNT(j)  (256  + 64 * (j))
#define XB_XSUB(j)  (1280 + 64 * (j))
#define XB_XGEN(j)  (2304 + 64 * (j))
#define XB_TOP      3328
#define XB_TOPGEN   3392
#define XCD_BAR_WORDS 3456
#define XB_SPIN_CAP (1u << 18)

__device__ __forceinline__ unsigned xb_ld(unsigned* p)              { return __hip_atomic_load(p, __ATOMIC_RELAXED, __HIP_MEMORY_SCOPE_AGENT); }
__device__ __forceinline__ unsigned xb_add(unsigned* p, unsigned v) { return __hip_atomic_fetch_add(p, v, __ATOMIC_RELAXED, __HIP_MEMORY_SCOPE_AGENT); }
__device__ __forceinline__ unsigned xb_xcc_id() { return (unsigned)__builtin_amdgcn_s_getreg((3 << 11) | 20) & 0xFu; }
#define XB_SPIN(cond, bar) do { unsigned _sp = 0; while (cond) { __builtin_amdgcn_s_sleep(1); \
    if ((++_sp & 255u) == 0u) { if (xb_ld(&(bar)[XB_TMO])) break; if (_sp > XB_SPIN_CAP) { atomicAdd(&(bar)[XB_TMO], 1u); break; } } } } while (0)

struct XcdBarrier {
    unsigned* bar; unsigned x; unsigned w;
    volatile LAS unsigned* st;
};

__device__ __forceinline__ XcdBarrier xcd_barrier_post(unsigned* bar, volatile LAS unsigned* st) {
    XcdBarrier b; b.bar = bar; b.x = xb_xcc_id(); b.st = st; b.w = 0u;
    if (threadIdx.x == 0) (void)xb_add(&bar[XB_XCNT(b.x)], 1u);
    return b;
}
__device__ __forceinline__ void xcd_barrier_complete(unsigned* bar, unsigned x, unsigned& nloc, unsigned& nx) {
    const unsigned G = gridDim.x * gridDim.y * gridDim.z;
    unsigned sum, cnt, mine, sp = 0u;
    for (;;) {
        sum = 0u; cnt = 0u; mine = 0u;
#pragma unroll
        for (unsigned j = 0; j < 16; ++j) { const unsigned c = xb_ld(&bar[XB_XCNT(j)]); sum += c; cnt += (c > 0u) ? 1u : 0u; mine = (j == x) ? c : mine; }
        if (sum == G) break;
        __builtin_amdgcn_s_sleep(1);
        if ((++sp & 255u) == 0u) { if (xb_ld(&bar[XB_TMO])) break; if (sp > XB_SPIN_CAP) { atomicAdd(&bar[XB_TMO], 1u); break; } }
    }
    nloc = mine > 0u ? mine : 1u; nx = cnt > 0u ? cnt : 1u;
}

__device__ __forceinline__ void xcd_barrier(const XcdBarrier& b) {
    asm volatile("s_waitcnt vmcnt(0)" ::: "memory");
    __syncthreads();
    if (b.w == 0u && lane_id() == 0) {
        unsigned* bar = b.bar;
        __builtin_amdgcn_s_waitcnt(0);
        unsigned nloc = b.st[0], nx = b.st[1];
        if (nloc == 0u) { xcd_barrier_complete(bar, b.x, nloc, nx); b.st[0] = nloc; b.st[1] = nx; }
        const unsigned old = xb_add(&bar[XB_XSUB(b.x)], 1u);
        const unsigned gen = old / nloc;
        if (old + 1u == (gen + 1u) * nloc) {
            __builtin_amdgcn_fence(__ATOMIC_RELEASE, "agent");
            asm volatile("s_waitcnt vmcnt(0)" ::: "memory");
            const unsigned og = xb_add(&bar[XB_TOP], 1u);
            const unsigned tg = og / nx;
            if (og + 1u == (tg + 1u) * nx) xb_add(&bar[XB_TOPGEN], 1u);
            else XB_SPIN(xb_ld(&bar[XB_TOPGEN]) == tg, bar);
            __builtin_amdgcn_fence(__ATOMIC_ACQUIRE, "agent");
            xb_add(&bar[XB_XGEN(b.x)], 1u);
            asm volatile("s_waitcnt vmcnt(0)" ::: "memory");
        } else {
            XB_SPIN(xb_ld(&bar[XB_XGEN(b.x)]) == gen, bar);
            __builtin_amdgcn_fence(__ATOMIC_ACQUIRE, "agent");
            asm volatile("s_waitcnt vmcnt(0)" ::: "memory");
        }
    }
    __syncthreads();
}


__global__ void __launch_bounds__(NWAVES * 64, 2) fwd_kernel(Args a) {
    extern __shared__ __attribute__((aligned(16))) unsigned char lds_raw[];
    LAS unsigned char* lds = (LAS unsigned char*)lds_raw;
    const int wave = __builtin_amdgcn_readfirstlane(threadIdx.x >> 6);
    const int G = gridDim.x, bx = blockIdx.x;
    unsigned char* ws = a.ws;
    float* ssq = (float*)(ws + WS_SSQ); bf16_t* xb = (bf16_t*)(ws + WS_XB);
    volatile LAS unsigned* misc = (volatile LAS unsigned*)(lds + MISC_OFF);
    if (threadIdx.x < 16) misc[threadIdx.x] = 0u;
    __syncthreads();
    XcdBarrier xbar = xcd_barrier_post((unsigned*)ws, misc); xbar.w = (unsigned)wave;
#define SEAM() xcd_barrier(xbar)
    if (a.ph_hi > 1000) cg::this_grid().sync();
    { const int vcu = (G % 8 == 0) ? (bx % 8) * (G / 8) + bx / 8 : bx; p0_prologue(a, lds, vcu * NWAVES + wave, G * NWAVES, lane_id(), wave); }
    SEAM();
    {
        pg8::Gemm g{xb, (const bf16_t*)(ws + WS_WIN), M, 2 * D, D}; pg8::StaticOrder S; S.init(M, 2 * D, G, bx);
        EpiU E{(bf16_t*)(ws + WS_U), ssq};
        pg8::gemm_phase<EpiU>(lds, g, S, E, wave);
    }
    SEAM();
    {
        LAS float* cw = (LAS float*)(lds + CW_OFF);
        for (int i = wave * 64 + lane_id(); i < 3 * D; i += NWAVES * 64) cw[i] = a.conv_w[i];
        __syncthreads();
        pg8::Gemm g{xb, (const bf16_t*)(ws + WS_WIN) + (size_t)2 * D * D, M, D, D}; pg8::StaticOrder S; S.init(M, D, G, bx);
        EpiCz E{(const bf16_t*)(ws + WS_U), (bf16_t*)(ws + WS_Z), ssq, cw};
        pg8::gemm_phase<EpiCz>(lds, g, S, E, wave);
    }
    SEAM();
    {
        pg8::Gemm g{(const bf16_t*)(ws + WS_Z), (const bf16_t*)(ws + WS_WOUT), M, D, D}; pg8::StaticOrder S; S.init(M, D, G, bx);
        EpiRes<1> E{nullptr, xb, nullptr, ssq};
        pg8::gemm_phase<EpiRes<1>, false>(lds, g, S, E, wave);
    }
    SEAM();
    {
        pg8::Gemm g{xb, (const bf16_t*)(ws + WS_GU0), M, 2 * DFF, D}; pg8::StaticOrder S; S.init(M, 2 * DFF, G, bx);
        EpiGu E{(bf16_t*)(ws + WS_ACT), ssq};
        pg8::gemm_phase<EpiGu>(lds, g, S, E, wave);
    }
    SEAM();
    {
        pg8::Gemm g{(const bf16_t*)(ws + WS_ACT), (const bf16_t*)(ws + WS_DN0), M, D, DFF}; pg8::StaticOrder S; S.init(M, D, G, bx);
        EpiRes<1> E{nullptr, xb, nullptr, ssq};
        pg8::gemm_phase<EpiRes<1>, false>(lds, g, S, E, wave);
    }
    SEAM();
    {
        pg8::Gemm g{xb, (const bf16_t*)(ws + WS_WQKV), M, NQKV, D}; pg8::StaticOrder S; S.init(M, NQKV, G, bx);
        EpiQkv E{(bf16_t*)(ws + WS_Q), (bf16_t*)(ws + WS_K), (bf16_t*)(ws + WS_VT), ssq, a.q_gain, a.k_gain};
        pg8::gemm_phase<EpiQkv>(lds, g, S, E, wave);
    }
    SEAM();
    attn_phase(a, lds, bx, G, wave);
    SEAM();
    {
        pg8::Gemm g{(const bf16_t*)(ws + WS_ATT), (const bf16_t*)(ws + WS_WO), M, D, D}; pg8::StaticOrder S; S.init(M, D, G, bx);
        EpiRes<1> E{nullptr, xb, nullptr, ssq};
        pg8::gemm_phase<EpiRes<1>, false>(lds, g, S, E, wave);
    }
    SEAM();
    {
        pg8::Gemm g{xb, (const bf16_t*)(ws + WS_GU1), M, 2 * DFF, D}; pg8::StaticOrder S; S.init(M, 2 * DFF, G, bx);
        EpiGu E{(bf16_t*)(ws + WS_ACT), ssq};
        pg8::gemm_phase<EpiGu>(lds, g, S, E, wave);
    }
    SEAM();
    {
        pg8::Gemm g{(const bf16_t*)(ws + WS_ACT), (const bf16_t*)(ws + WS_DN1), M, D, DFF}; pg8::StaticOrder S; S.init(M, D, G, bx);
        EpiRes<2> E{nullptr, xb, a.out, nullptr};
        pg8::gemm_phase<EpiRes<2>, false>(lds, g, S, E, wave);
    }
#undef SEAM
}

extern "C" void kernel_launch(void* const* d_in, const int* in_sizes, int n_in, void* d_out, int out_size, void* d_ws, size_t ws_size, hipStream_t stream) {
    static int grid = 0;
    if (grid == 0) {
        if (n_in != 13 || in_sizes[0] != M * D || out_size != M * D || ws_size < WS_END) { fprintf(stderr, "kernel_launch: unexpected shapes (n_in %d, in0 %d, out %d, ws %zu)\n", n_in, n_in > 0 ? in_sizes[0] : -1, out_size, ws_size); grid = -1; return; }
        int dev = 0, cus = 0, per_cu = 0;
        if (hipGetDevice(&dev) != hipSuccess || hipDeviceGetAttribute(&cus, hipDeviceAttributeMultiprocessorCount, dev) != hipSuccess) { grid = -1; return; }
        if (hipFuncSetAttribute((const void*)fwd_kernel, hipFuncAttributeMaxDynamicSharedMemorySize, LDS_BYTES) != hipSuccess) { fprintf(stderr, "kernel_launch: hipFuncSetAttribute failed\n"); grid = -1; return; }
        if (hipOccupancyMaxActiveBlocksPerMultiprocessor(&per_cu, (const void*)fwd_kernel, NWAVES * 64, LDS_BYTES) != hipSuccess || per_cu < 1) { fprintf(stderr, "kernel_launch: occupancy query gave %d\n", per_cu); per_cu = 1; }
        (void)hipGetLastError();
        grid = cus * 1;
    }
    if (grid < 0) return;
    if (hipMemsetAsync(d_ws, 0, 16384, stream) != hipSuccess) { fprintf(stderr, "kernel_launch: hipMemsetAsync failed\n"); return; }
    Args a{};
    a.x = (const float*)d_in[0]; a.conv_w_in = (const float*)d_in[1]; a.conv_w = (const float*)d_in[2]; a.conv_w_out = (const float*)d_in[3];
    a.w_qkv = (const float*)d_in[4]; a.q_gain = (const float*)d_in[5]; a.k_gain = (const float*)d_in[6]; a.sinks = (const float*)d_in[7];
    a.w_o = (const float*)d_in[8]; a.norm_mixer = (const float*)d_in[9]; a.norm_ffn = (const float*)d_in[10]; a.w_gu = (const float*)d_in[11]; a.w_dn = (const float*)d_in[12];
    a.out = (float*)d_out; a.ws = (unsigned char*)d_ws;
    a.ph_lo = 0; a.ph_hi = 11;
    void* args[] = {&a};
    hipError_t e = hipLaunchCooperativeKernel((const void*)fwd_kernel, dim3(grid), dim3(NWAVES * 64), args, LDS_BYTES, stream);
    if (e != hipSuccess) fprintf(stderr, "cooperative launch failed: %s (grid %d)\n", hipGetErrorString(e), grid);
}
```
